# Optimizing an MI355X kernel written in HIP

```python
import jax, jax.numpy as jnp
from jax import lax
import numpy as np

D_MODEL = 1024
BATCH = 2
SEQ = 16384
DEPTH = 4

CHUNK = 64
EPS = 1e-6
D_A = D_MODEL
CONV_A = 3
D_B = D_MODEL
LRU_HEADS = 16
LRU_BW = D_B // LRU_HEADS
CONV_B = 4
LRU_C = 8.0
D_C = D_MODEL
RWKV_HEAD = 64
RWKV_HEADS = D_C // RWKV_HEAD
R_W = 64
R_A = 64
R_V = 32
R_G = 128
LNX_EPS = RWKV_HEAD * 1e-5
D_FF = 4 * D_MODEL
N_BRANCH = 3
COLS_A = 3 * D_A
COLS_B = 2 * D_B
COLS_GATE = N_BRANCH * D_MODEL
COLS_C = 3 * D_C + R_W + R_A + R_G
N_IN = COLS_A + COLS_B + COLS_GATE + COLS_C

kernel_name = "hybrid_conv_rglru_rwkv7_block"


def _split(t, sizes):
    out, o = [], 0
    for s in sizes:
        out.append(t[..., o:o + s])
        o += s
    return out


def rms_norm(x, g):
    xf = x.astype(jnp.float32)
    y = xf * lax.rsqrt(jnp.mean(xf * xf, axis=-1, keepdims=True) + EPS)
    return (y * g.astype(jnp.float32)).astype(x.dtype)


def causal_dwconv(x, w, b=None):
    K = w.shape[0]
    S = x.shape[1]
    xp = jnp.pad(x, ((0, 0), (K - 1, 0), (0, 0)))
    y = xp[:, K - 1:K - 1 + S] * w[K - 1]
    for j in range(K - 1):
        y = y + xp[:, j:j + S] * w[j]
    return y if b is None else y + b


def token_shift(p, mu):
    prev = jnp.pad(p, ((0, 0), (1, 0), (0, 0)))[:, :-1]
    return p + (prev - p) * mu


def rg_lru(x, w_a, b_a, w_i, b_i, a_param):
    Bsz, S, C = x.shape
    f32 = jnp.float32
    xb = x.reshape(Bsz, S, LRU_HEADS, LRU_BW)
    gate_a = jax.nn.sigmoid((jnp.einsum('bshi,hij->bshj', xb, w_a).reshape(Bsz, S, C) + b_a).astype(f32))
    gate_i = jax.nn.sigmoid((jnp.einsum('bshi,hij->bshj', xb, w_i).reshape(Bsz, S, C) + b_i).astype(f32))
    log_a = -LRU_C * gate_a * jax.nn.softplus(a_param.astype(f32))
    a = jnp.exp(log_a)
    mult = jnp.sqrt(-jnp.expm1(2.0 * log_a))
    mult = jnp.where(jnp.arange(S)[None, :, None] == 0, 1.0, mult)
    u = x.astype(f32) * gate_i * mult

    def combine(left, right):
        a_l, u_l = left
        a_r, u_r = right
        return a_l * a_r, a_r * u_l + u_r

    _, h = lax.associative_scan(combine, (a, u), axis=1)
    return h.astype(x.dtype)


def rwkv7_recurrence(r, decay, k, v, kk, a):
    Bsz, S, H, N = r.shape
    nc = S // CHUNK

    def to_chunks(t):
        return t.reshape(Bsz, nc, CHUNK, H, N).transpose(1, 2, 0, 3, 4)

    def step(state, inp):
        r_t, w_t, k_t, v_t, kk_t, a_t = inp
        sa = jnp.einsum('bhvk,bhk->bhv', state, -kk_t)
        state = (state * w_t[:, :, None, :]
                 + sa[..., None] * (kk_t * a_t)[:, :, None, :]
                 + v_t[..., None] * k_t[:, :, None, :])
        y_t = jnp.einsum('bhvk,bhk->bhv', state, r_t)
        return state, y_t

    def chunk_step(state, chunk_inp):
        return lax.scan(step, state, chunk_inp)

    state0 = jnp.zeros((Bsz, H, N, N), jnp.float32)
    inputs = (to_chunks(r), to_chunks(decay), to_chunks(k), to_chunks(v), to_chunks(kk), to_chunks(a))
    _, y = lax.scan(chunk_step, state0, inputs)
    return y.transpose(2, 0, 1, 3, 4).reshape(Bsz, S, H, N)


def rwkv7_mix(pc, h, v_first, w0, w2, a0, a2, g2, k_k, k_a, r_k, lnx_g, lnx_b, vres):
    f32 = jnp.float32
    r, k, v, xw, xa, xg = _split(pc, (D_C, D_C, D_C, R_W, R_A, R_G))
    w_log = -jax.nn.softplus(-(w0 + jnp.tanh(xw) @ w2).astype(f32)) - 0.5
    decay = jnp.exp(-jnp.exp(w_log))
    if vres is None:
        v_first = v
    else:
        v0, v1, v2 = vres
        v = v + (v_first - v) * jax.nn.sigmoid(v0 + (h @ v1) @ v2)
    a = jax.nn.sigmoid(a0 + xa @ a2)
    g = jax.nn.sigmoid(xg) @ g2

    def heads(t):
        return t.reshape(t.shape[:-1] + (RWKV_HEADS, RWKV_HEAD)).astype(f32)

    kk = heads(k * k_k)
    kk = kk / jnp.maximum(jnp.sqrt(jnp.sum(kk * kk, axis=-1, keepdims=True)), 1e-12)
    k = k * (1.0 + (a - 1.0) * k_a)
    rh, kh, vh, ah = heads(r), heads(k), heads(v), heads(a)
    y = rwkv7_recurrence(rh, heads(decay), kh, vh, kk, ah)
    mu = jnp.mean(y, axis=-1, keepdims=True)
    var = jnp.mean(jnp.square(y - mu), axis=-1, keepdims=True)
    y = (y - mu) * lax.rsqrt(var + LNX_EPS)
    y = y + jnp.sum(rh * kh * r_k.astype(f32), axis=-1, keepdims=True) * vh
    y = y.reshape(y.shape[:2] + (D_C,))
    return y, g, v_first


def setup_inputs(seed: int = 0) -> dict:
    key = jax.random.key(seed)
    ks = iter(jax.random.split(key, 48))
    L = DEPTH

    def nrm(shape, scale):
        return jax.random.normal(next(ks), shape, jnp.float32) * scale

    def uni(shape, lo, hi):
        return jax.random.uniform(next(ks), shape, jnp.float32, lo, hi)

    rad = uni((L, D_B), 0.9, 0.999)
    lru_a_param = jnp.log(jnp.expm1(-jnp.log(rad)))
    LV = max(L - 1, 0)
    return {
        "x": nrm((BATCH, SEQ, D_MODEL), 1.0),
        "norm1_g": 1.0 + nrm((L, D_MODEL), 0.05),
        "w_in": nrm((L, D_MODEL, N_IN), D_MODEL ** -0.5),
        "merge_b": nrm((L, COLS_GATE), 0.01),
        "conv_a_w": nrm((L, CONV_A, D_A), CONV_A ** -0.5),
        "lru_conv_w": nrm((L, CONV_B, D_B), CONV_B ** -0.5),
        "lru_conv_b": nrm((L, D_B), 0.01),
        "lru_wa": nrm((L, LRU_HEADS, LRU_BW, LRU_BW), LRU_BW ** -0.5),
        "lru_ba": nrm((L, D_B), 0.01),
        "lru_wi": nrm((L, LRU_HEADS, LRU_BW, LRU_BW), LRU_BW ** -0.5),
        "lru_bi": nrm((L, D_B), 0.01),
        "lru_a_param": lru_a_param,
        "rwkv_mu": uni((L, COLS_C), 0.0, 1.0),
        "rwkv_w0": uni((L, D_C), -6.0, 1.0),
        "rwkv_w2": nrm((L, R_W, D_C), 0.1 * R_W ** -0.5),
        "rwkv_a0": nrm((L, D_C), 0.1),
        "rwkv_a2": nrm((L, R_A, D_C), 0.1 * R_A ** -0.5),
        "rwkv_g2": nrm((L, R_G, D_C), R_G ** -0.5),
        "rwkv_kk": 0.85 + nrm((L, D_C), 0.05),
        "rwkv_ka": 1.0 + nrm((L, D_C), 0.05),
        "rwkv_rk": nrm((L, RWKV_HEADS, RWKV_HEAD), 0.1),
        "rwkv_lnx_g": 1.0 + nrm((L, D_C), 0.05),
        "rwkv_lnx_b": nrm((L, D_C), 0.01),
        "rwkv_v0": 1.0 + nrm((LV, D_C), 0.1),
        "rwkv_v1": nrm((LV, D_MODEL, R_V), D_MODEL ** -0.5),
        "rwkv_v2": nrm((LV, R_V, D_C), 0.1 * R_V ** -0.5),
        "w_out": nrm((L, D_MODEL, D_MODEL), D_MODEL ** -0.5),
        "norm2_g": 1.0 + nrm((L, D_MODEL), 0.05),
        "mlp_w1": nrm((L, D_MODEL, D_FF), D_MODEL ** -0.5),
        "mlp_w2": nrm((L, D_FF, D_MODEL), D_FF ** -0.5),
        "final_g": 1.0 + nrm((D_MODEL,), 0.05),
    }


def reference(x, norm1_g, w_in, merge_b, conv_a_w, lru_conv_w, lru_conv_b, lru_wa, lru_ba, lru_wi,
              lru_bi, lru_a_param, rwkv_mu, rwkv_w0, rwkv_w2, rwkv_a0, rwkv_a2, rwkv_g2, rwkv_kk,
              rwkv_ka, rwkv_rk, rwkv_lnx_g, rwkv_lnx_b, rwkv_v0, rwkv_v1, rwkv_v2, w_out, norm2_g,
              mlp_w1, mlp_w2, final_g):
    v_first = None
    for l in range(DEPTH):
        h = rms_norm(x, norm1_g[l])
        p = h @ w_in[l]
        pa, pb, pg, pc = _split(p, (COLS_A, COLS_B, COLS_GATE, COLS_C))

        b_a, c_a, x_a = _split(pa, (D_A, D_A, D_A))
        y_a = b_a * causal_dwconv(c_a * x_a, conv_a_w[l])

        x_b, g_b = _split(pb, (D_B, D_B))
        u = causal_dwconv(x_b, lru_conv_w[l], lru_conv_b[l])
        y_b = rg_lru(u, lru_wa[l], lru_ba[l], lru_wi[l], lru_bi[l], lru_a_param[l]) * jax.nn.gelu(g_b, approximate=True)

        pc = token_shift(pc, rwkv_mu[l])
        vres = None if l == 0 else (rwkv_v0[l - 1], rwkv_v1[l - 1], rwkv_v2[l - 1])
        f32 = jnp.float32
        r, k, v, xw, xa, xg = _split(pc, (D_C, D_C, D_C, R_W, R_A, R_G))
        w_log = -jax.nn.softplus(-(rwkv_w0[l] + jnp.tanh(xw) @ rwkv_w2[l]).astype(f32)) - 0.5
        decay = jnp.exp(-jnp.exp(w_log))
        if vres is None:
            v_first = v
        else:
            v0, v1, v2 = vres
            v = v + (v_first - v) * jax.nn.sigmoid(v0 + (h @ v1) @ v2)
        a = jax.nn.sigmoid(rwkv_a0[l] + xa @ rwkv_a2[l])
        g_c = jax.nn.sigmoid(xg) @ rwkv_g2[l]
        hs = x.shape[:2] + (RWKV_HEADS, RWKV_HEAD)
        kk = (k * rwkv_kk[l]).astype(f32).reshape(hs)
        kk = kk / jnp.maximum(jnp.sqrt(jnp.sum(kk * kk, axis=-1, keepdims=True)), 1e-12)
        k = k * (1.0 + (a - 1.0) * rwkv_ka[l])
        rh = r.astype(f32).reshape(hs)
        kh = k.astype(f32).reshape(hs)
        vh = v.astype(f32).reshape(hs)
        ah = a.astype(f32).reshape(hs)
        yc = rwkv7_recurrence(rh, decay.reshape(hs), kh, vh, kk, ah)
        mu = jnp.mean(yc, axis=-1, keepdims=True)
        var = jnp.mean(jnp.square(yc - mu), axis=-1, keepdims=True)
        yc = ((yc - mu) * lax.rsqrt(var + LNX_EPS)).reshape(x.shape[:2] + (D_C,))
        yc = yc * rwkv_lnx_g[l].astype(f32) + rwkv_lnx_b[l].astype(f32)
        bonus = jnp.sum(rh * kh * rwkv_rk[l].astype(f32), axis=-1, keepdims=True) * vh
        yc = yc + bonus.reshape(x.shape[:2] + (D_C,))
        y_c = (yc * g_c.astype(f32)).astype(x.dtype)

        gate_a, gate_b, gate_c = _split(jax.nn.sigmoid(pg + merge_b[l]), (D_MODEL, D_MODEL, D_MODEL))
        m = gate_a * y_a + gate_b * y_b + gate_c * y_c
        x = x + m @ w_out[l]

        h2 = rms_norm(x, norm2_g[l])
        x = x + jnp.square(jax.nn.relu(h2 @ mlp_w1[l])) @ mlp_w2[l]
    return rms_norm(x, final_g)
```

```cpp
#include <hip/hip_runtime.h>
#include <hip/hip_cooperative_groups.h>
#include <cstdio>
#include <cstdint>
namespace cg = cooperative_groups;
namespace pg8 {
#define PG8_LAS __attribute__((address_space(3)))
typedef unsigned short bf16_t;
typedef short bf16x8 __attribute__((ext_vector_type(8)));
typedef float f32x4 __attribute__((ext_vector_type(4)));
typedef unsigned u32x4 __attribute__((ext_vector_type(4)));
constexpr int BM = 256, BK = 64, HALF = 128, HTB = HALF * BK * 2  , STAGE_BYTES = 8 * HTB, NXCD = 8, WGM = 8;

__host__ __device__ __forceinline__ int lds_byte(int r, int c) { const int st = (r >> 4) * 2 + (c >> 5), rr = r & 15, cc = c & 31, ob = rr * 64 + cc * 2; return st * 1024 + (ob ^ (((ob >> 9) & 1) << 5)); }
__host__ __device__ __forceinline__ void stage_rc(int b, int& R, int& C) { const int st = b / 1024, sb = b % 1024, swz = sb ^ (((sb >> 9) & 1) << 5); R = (st >> 1) * 16 + swz / 64; C = (st & 1) * 32 + (swz % 64) / 2; }
__host__ __device__ __forceinline__ int perm32(int rho) { const int n = rho >> 4, i = rho & 15; return 8 * (i >> 2) + 4 * n + (i & 3); }

struct Unit { int pm, pn; };
struct Gemm { const bf16_t* A; const bf16_t* Bt; int M, N, K; };

struct StaticOrder {
    int nM, nN, nwg, G, c;
    __host__ __device__ void init(int M, int N, int G_, int c_) { nM = M / BM; nN = N / BM; nwg = nM * nN; G = G_; c = c_; }
    __host__ __device__ bool next(int i, Unit& u) const {
        const long L = (long)i * G + c; if (L >= nwg) return false;
        int wgid = (int)L; { const int q = nwg / NXCD, r = nwg % NXCD, xcd = wgid % NXCD, off = wgid / NXCD; wgid = (xcd < r ? xcd * (q + 1) : r * (q + 1) + (xcd - r) * q) + off; }
        const int nig = WGM * nN, gid = wgid / nig, fm = gid * WGM, gsz = (nM - fm) < WGM ? (nM - fm) : WGM;
        u.pm = fm + ((wgid % nig) % gsz); u.pn = (wgid % nig) / gsz; return true;
    }
    __device__ __forceinline__ void a_ready(const Unit&) const {}
    __device__ __forceinline__ void done(const Unit&) const {}
};
__device__ __forceinline__ unsigned cvt_pk_bf16(float lo, float hi) { unsigned r; asm volatile("v_cvt_pk_bf16_f32 %0, %1, %2" : "=v"(r) : "v"(lo), "v"(hi)); return r; }
__device__ __forceinline__ float fsigmoid(float x) { return __builtin_amdgcn_rcpf(1.0f + __expf(-x)); }
__device__ __forceinline__ float gelu_tanh(float x) { const float z = 1.5957691216f * (x + 0.044715f * x * x * x); return x * fsigmoid(z); }
__device__ __forceinline__ u32x4 pack8(const f32x4 a, const f32x4 b) { u32x4 w; w.x = cvt_pk_bf16(a[0], a[1]); w.y = cvt_pk_bf16(a[2], a[3]); w.z = cvt_pk_bf16(b[0], b[1]); w.w = cvt_pk_bf16(b[2], b[3]); return w; }

struct EpiIn {
    static constexpr bool PERM = true, AFTER_DRAIN = false;
    bf16_t *EB, *XS, *HV; const float* mb;
    __device__ __forceinline__ void operator()(const f32x4 (&acc)[2][2][4][2], const Unit& u, int wr, int wc, int fr, int fq) const {
        const int t = u.pn, row0 = u.pm * BM + wr * 64 + fr, cl = wc * 32 + 8 * fq;
        if (t < 24) {
            const int kind = t >> 3, ch = 128 * (t & 7) + cl;
            bf16_t* O = EB + (size_t)(kind == 2 ? 3 : kind) * ((size_t)32768 * 1024);
            f32x4 b0 = (f32x4){0.f, 0.f, 0.f, 0.f}, b1 = b0;
            if (kind != 1) { const float* mp = mb + (kind == 0 ? 0 : 1024) + ch; b0 = *(const f32x4*)mp; b1 = *(const f32x4*)(mp + 4); }
#pragma unroll
            for (int ai = 0; ai < 2; ++ai)
#pragma unroll
                for (int m = 0; m < 4; ++m) {
                    const f32x4 x0 = acc[ai][0][m][0], x1 = acc[ai][0][m][1], y0 = acc[ai][1][m][0] + b0, y1 = acc[ai][1][m][1] + b1;
                    f32x4 o0, o1;
#pragma unroll
                    for (int e = 0; e < 4; ++e) {
                        if (kind == 0) { o0[e] = x0[e] * fsigmoid(y0[e]); o1[e] = x1[e] * fsigmoid(y1[e]); }
                        else if (kind == 1) { o0[e] = x0[e] * y0[e]; o1[e] = x1[e] * y1[e]; }
                        else { o0[e] = gelu_tanh(x0[e]) * fsigmoid(y0[e]); o1[e] = gelu_tanh(x1[e]) * fsigmoid(y1[e]); }
                    }
                    *(u32x4*)(O + (size_t)(row0 + ai * HALF + m * 16) * 1024 + ch) = pack8(o0, o1);
                }
        } else if (t < 45) {
            bf16_t* O; int ld = 1024; const bool sg = (t >= 28 && t < 32); const int cb = (t < 44) ? 256 * (t & 3) : 0;
            if (t < 44) { const int idx = (t < 28) ? 2 : (t < 32 ? 4 : 5 + ((t - 32) >> 2)); O = EB + (size_t)idx * ((size_t)32768 * 1024); }
            else { O = XS; ld = 256; }
#pragma unroll
            for (int bj = 0; bj < 2; ++bj) {
                const int ch = cb + bj * HALF + cl;
                f32x4 b0 = (f32x4){0.f, 0.f, 0.f, 0.f}, b1 = b0;
                if (sg) { b0 = *(const f32x4*)(mb + 2048 + ch); b1 = *(const f32x4*)(mb + 2048 + ch + 4); }
#pragma unroll
                for (int ai = 0; ai < 2; ++ai)
#pragma unroll
                    for (int m = 0; m < 4; ++m) {
                        f32x4 o0 = acc[ai][bj][m][0], o1 = acc[ai][bj][m][1];
                        if (sg) {
#pragma unroll
                            for (int e = 0; e < 4; ++e) { o0[e] = fsigmoid(o0[e] + b0[e]); o1[e] = fsigmoid(o1[e] + b1[e]); }
                        }
                        *(u32x4*)(O + (size_t)(row0 + ai * HALF + m * 16) * ld + ch) = pack8(o0, o1);
                    }
            }
        } else {
            if (wc == 0) {
#pragma unroll
                for (int ai = 0; ai < 2; ++ai)
#pragma unroll
                    for (int m = 0; m < 4; ++m)
                        *(u32x4*)(HV + (size_t)(row0 + ai * HALF + m * 16) * 32 + cl) = pack8(acc[ai][0][m][0], acc[ai][0][m][1]);
            }
        }
    }
};
struct EpiRes {
    static constexpr bool PERM = false, AFTER_DRAIN = false;
    const float* base; float* out;
    __device__ __forceinline__ void operator()(const f32x4 (&acc)[2][2][4][2], const Unit& u, int wr, int wc, int fr, int fq) const {
        const int row0 = u.pm * BM + wr * 64 + fr, col0 = u.pn * BM + wc * 32 + 4 * fq;
#pragma unroll
        for (int ai = 0; ai < 2; ++ai) {
            f32x4 pre[4][2][2];
#pragma unroll
            for (int m = 0; m < 4; ++m) { const size_t off = (size_t)(row0 + ai * HALF + m * 16) * 1024 + col0;
#pragma unroll
                for (int bj = 0; bj < 2; ++bj)
#pragma unroll
                    for (int n = 0; n < 2; ++n) pre[m][bj][n] = *(const f32x4*)(base + off + bj * HALF + n * 16); }
            asm volatile("" ::: "memory");
#pragma unroll
            for (int m = 0; m < 4; ++m) { const size_t off = (size_t)(row0 + ai * HALF + m * 16) * 1024 + col0;
#pragma unroll
                for (int bj = 0; bj < 2; ++bj)
#pragma unroll
                    for (int n = 0; n < 2; ++n) *(f32x4*)(out + off + bj * HALF + n * 16) = pre[m][bj][n] + acc[ai][bj][m][n]; }
            asm volatile("" ::: "memory");
        }
    }
};
struct EpiRelu2 {
    static constexpr bool PERM = true, AFTER_DRAIN = false;
    bf16_t* O;
    __device__ __forceinline__ void operator()(const f32x4 (&acc)[2][2][4][2], const Unit& u, int wr, int wc, int fr, int fq) const {
        const int row0 = u.pm * BM + wr * 64 + fr, col0 = u.pn * BM + wc * 32 + 8 * fq;
#pragma unroll
        for (int ai = 0; ai < 2; ++ai)
#pragma unroll
            for (int m = 0; m < 4; ++m) { bf16_t* rowp = O + (size_t)(row0 + ai * HALF + m * 16) * 4096 + col0;
#pragma unroll
                for (int bj = 0; bj < 2; ++bj) { f32x4 v0 = acc[ai][bj][m][0], v1 = acc[ai][bj][m][1];
#pragma unroll
                    for (int e = 0; e < 4; ++e) { const float a = fmaxf(v0[e], 0.f), b = fmaxf(v1[e], 0.f); v0[e] = a * a; v1[e] = b * b; }
                    *(u32x4*)(rowp + bj * HALF) = pack8(v0, v1); } }
    }
};

template <class Epi, class Sched, bool ALIGN_EPI = false, bool SP2 = false>
__device__ __forceinline__ void gemm_phase(PG8_LAS unsigned char* lds, const Gemm g, const Sched& S, const Epi& E) {
    int tid_ = threadIdx.x; asm volatile("" : "+v"(tid_));
    const int tid = tid_, wid = __builtin_amdgcn_readfirstlane(tid >> 6), lane = tid & 63, wr = wid >> 2, wc = wid & 3, fr = lane & 15, fq = lane >> 4;
    const int K = g.K, nt = K / BK;
    unsigned voffA[2], voffB[2];
#pragma unroll
    for (int i = 0; i < 2; ++i) { int R, C; stage_rc(tid * 16 + i * 8192, R, C); const int Rb = Epi::PERM ? ((R & ~31) + perm32(R & 31)) : R;
        voffA[i] = (unsigned)(R * K + C) * 2u; voffB[i] = (unsigned)(Rb * K + C) * 2u; }
    const size_t kstep = (size_t)(BK * 2);
    const size_t hstep = (size_t)HALF * K * 2;
    const size_t tstep = 2 * hstep;
    const unsigned ldsw = (unsigned)wid * 1024u;
    const int aoff = lds_byte(wr * 64 + fr, fq * 8), boff = lds_byte(wc * 32 + fr, fq * 8);
#define PG8_SA(b, h) (((b) * 2 + (h)) * HTB)
#define PG8_SB(b, h) ((4 + (b) * 2 + (h)) * HTB)
#define PG8_STAGE(bufoff, gbase, voff) do { _Pragma("unroll") for (int _i = 0; _i < 2; ++_i) \
        __builtin_amdgcn_global_load_lds((const unsigned*)((const char*)(gbase) + (voff)[_i]), (PG8_LAS unsigned*)(lds + (bufoff) + ldsw + _i * 8192), 16, 0, 0); } while (0)
#define PG8_LDA(dst, b, h) do { _Pragma("unroll") for (int m = 0; m < 4; ++m) _Pragma("unroll") for (int k = 0; k < 2; ++k) dst[m][k] = *(const PG8_LAS bf16x8*)(lds + PG8_SA(b, h) + aoff + m * 2048 + k * 1024); } while (0)
#define PG8_LDB(dst, b, h) do { _Pragma("unroll") for (int n = 0; n < 2; ++n) _Pragma("unroll") for (int k = 0; k < 2; ++k) dst[n][k] = *(const PG8_LAS bf16x8*)(lds + PG8_SB(b, h) + boff + n * 2048 + k * 1024); } while (0)
#define PG8_MMA(ai, bj, At, Bt) do { __builtin_amdgcn_s_setprio(1); _Pragma("unroll") for (int m = 0; m < 4; ++m) _Pragma("unroll") for (int n = 0; n < 2; ++n) _Pragma("unroll") for (int k = 0; k < 2; ++k) \
        acc[ai][bj][m][n] = __builtin_amdgcn_mfma_f32_16x16x32_bf16(Bt[n][k], At[m][k], acc[ai][bj][m][n], 0, 0, 0); __builtin_amdgcn_s_setprio(0); } while (0)
#define PG8_WAIT_V(n) asm volatile("s_waitcnt vmcnt(" #n ")" ::: "memory")
#define PG8_WAIT_L(n) asm volatile("s_waitcnt lgkmcnt(" #n ")" ::: "memory")
#define PG8_BAR __builtin_amdgcn_s_barrier()
#define PG8_SCHED __builtin_amdgcn_sched_barrier(0)
    Unit cur, nxt; int ui = 0;
    if (!S.next(0, cur)) return;
    f32x4 acc[2][2][4][2];
#pragma unroll
    for (int a = 0; a < 2; ++a)
#pragma unroll
        for (int b = 0; b < 2; ++b)
#pragma unroll
            for (int m = 0; m < 4; ++m)
#pragma unroll
                for (int n = 0; n < 2; ++n) acc[a][b][m][n] = (f32x4){0.f, 0.f, 0.f, 0.f};
    bf16x8 At[4][2], B0[2][2], B1[2][2];
    const char* cA = (const char*)g.A + (size_t)cur.pm * tstep; const char* cB = (const char*)g.Bt + (size_t)cur.pn * tstep;
    S.a_ready(cur);
    if constexpr (SP2) {
        PG8_STAGE(PG8_SB(0, 0), cB, voffB); PG8_STAGE(PG8_SB(0, 1), cB + hstep, voffB); PG8_STAGE(PG8_SA(0, 0), cA, voffA); PG8_STAGE(PG8_SA(0, 1), cA + hstep, voffA);
        if (wr == 1) PG8_BAR;
        PG8_WAIT_V(2); PG8_BAR;
        PG8_STAGE(PG8_SB(1, 0), cB + kstep, voffB); PG8_STAGE(PG8_SA(1, 0), cA + kstep, voffA); PG8_STAGE(PG8_SB(1, 1), cB + hstep + kstep, voffB);
        PG8_WAIT_V(6); PG8_BAR;
    } else {
        PG8_STAGE(PG8_SB(0, 0), cB, voffB); PG8_STAGE(PG8_SA(0, 0), cA, voffA); PG8_STAGE(PG8_SB(0, 1), cB + hstep, voffB); PG8_STAGE(PG8_SA(0, 1), cA + hstep, voffA);
        if (wr == 1) PG8_BAR;
        PG8_WAIT_V(4); PG8_BAR;
        PG8_STAGE(PG8_SB(1, 0), cB + kstep, voffB); PG8_STAGE(PG8_SA(1, 0), cA + kstep, voffA); PG8_STAGE(PG8_SB(1, 1), cB + hstep + kstep, voffB);
        PG8_WAIT_V(6); PG8_BAR;
    }
    for (;;) {
        const bool has_next = S.next(ui + 1, nxt);
        const char* nA = has_next ? (const char*)g.A + (size_t)nxt.pm * tstep : cA; const char* nB = has_next ? (const char*)g.Bt + (size_t)nxt.pn * tstep : cB;
        for (int t = 0; t < nt; t += 2) {
            const bool last = (t == nt - 2);
            const char* a1 = cA + (size_t)(t + 1) * kstep;
            const char* a2 = last ? nA : cA + (size_t)(t + 2) * kstep; const char* b2 = last ? nB : cB + (size_t)(t + 2) * kstep;
            const char* a3 = a2 + kstep; const char* b3 = b2 + kstep;
            if (last && has_next) S.a_ready(nxt);
            if constexpr (SP2) {
            PG8_LDB(B0, 0, 0); PG8_LDB(B1, 0, 1); PG8_SCHED; PG8_LDA(At, 0, 0); PG8_STAGE(PG8_SA(1, 1), a1 + hstep, voffA);
            PG8_WAIT_V(8); PG8_WAIT_L(0); PG8_BAR; PG8_MMA(0, 0, At, B0); PG8_MMA(0, 1, At, B1); PG8_BAR; PG8_SCHED;
            PG8_LDA(At, 0, 1); PG8_STAGE(PG8_SB(0, 0), b2, voffB); PG8_STAGE(PG8_SB(0, 1), b2 + hstep, voffB); PG8_STAGE(PG8_SA(0, 0), a2, voffA);
            PG8_WAIT_V(8); PG8_WAIT_L(0); PG8_BAR; PG8_MMA(1, 0, At, B0); PG8_MMA(1, 1, At, B1); PG8_BAR; PG8_SCHED;
            PG8_LDB(B0, 1, 0); PG8_LDB(B1, 1, 1); PG8_SCHED; PG8_LDA(At, 1, 0); PG8_STAGE(PG8_SA(0, 1), a2 + hstep, voffA);
            PG8_WAIT_V(8); PG8_WAIT_L(0); PG8_BAR; PG8_MMA(0, 0, At, B0); PG8_MMA(0, 1, At, B1); PG8_BAR; PG8_SCHED;
            PG8_LDA(At, 1, 1); PG8_STAGE(PG8_SB(1, 0), b3, voffB); PG8_STAGE(PG8_SB(1, 1), b3 + hstep, voffB); PG8_STAGE(PG8_SA(1, 0), a3, voffA);
            PG8_WAIT_V(8); PG8_WAIT_L(0); PG8_BAR; PG8_MMA(1, 0, At, B0); PG8_MMA(1, 1, At, B1); PG8_BAR; PG8_SCHED;
            } else {
            PG8_LDB(B0, 0, 0); PG8_SCHED; PG8_LDA(At, 0, 0); PG8_STAGE(PG8_SA(1, 1), a1 + hstep, voffA);
            PG8_WAIT_L(8); PG8_BAR; PG8_WAIT_L(0); PG8_MMA(0, 0, At, B0); PG8_BAR; PG8_SCHED;
            PG8_LDB(B1, 0, 1); PG8_STAGE(PG8_SB(0, 0), b2, voffB);
            PG8_BAR; PG8_WAIT_L(0); PG8_MMA(0, 1, At, B1); PG8_BAR;
            PG8_LDA(At, 0, 1); PG8_STAGE(PG8_SA(0, 0), a2, voffA);
            PG8_BAR; PG8_WAIT_L(0); PG8_MMA(1, 0, At, B0); PG8_BAR; PG8_SCHED;
            PG8_STAGE(PG8_SB(0, 1), b2 + hstep, voffB);
            PG8_WAIT_V(6); PG8_BAR; PG8_MMA(1, 1, At, B1); PG8_BAR;
            PG8_LDB(B0, 1, 0); PG8_SCHED; PG8_LDA(At, 1, 0); PG8_STAGE(PG8_SA(0, 1), a2 + hstep, voffA);
            PG8_WAIT_L(8); PG8_BAR; PG8_WAIT_L(0); PG8_MMA(0, 0, At, B0); PG8_BAR; PG8_SCHED;
            PG8_LDB(B1, 1, 1); PG8_STAGE(PG8_SB(1, 0), b3, voffB);
            PG8_BAR; PG8_WAIT_L(0); PG8_MMA(0, 1, At, B1); PG8_BAR;
            PG8_LDA(At, 1, 1); PG8_STAGE(PG8_SA(1, 0), a3, voffA);
            PG8_BAR; PG8_WAIT_L(0); PG8_MMA(1, 0, At, B0); PG8_BAR; PG8_SCHED;
            PG8_STAGE(PG8_SB(1, 1), b3 + hstep, voffB);
            PG8_WAIT_V(6); PG8_BAR; PG8_MMA(1, 1, At, B1); PG8_BAR;
            }
        }
        if constexpr (ALIGN_EPI) { if (wr == 0) PG8_BAR; }
        if constexpr (!Epi::AFTER_DRAIN) { E(acc, cur, wr, wc, fr, fq); S.done(cur); __builtin_amdgcn_s_waitcnt(0x0F70);   }
        if (!has_next) break;
#pragma unroll
        for (int a = 0; a < 2; ++a)
#pragma unroll
            for (int b = 0; b < 2; ++b)
#pragma unroll
                for (int m = 0; m < 4; ++m)
#pragma unroll
                    for (int n = 0; n < 2; ++n) acc[a][b][m][n] = (f32x4){0.f, 0.f, 0.f, 0.f};
        cur = nxt; cA = nA; cB = nB; ++ui;
        if constexpr (ALIGN_EPI) { if (wr == 1) PG8_BAR; }
    }
    PG8_WAIT_V(0);
    if constexpr (!ALIGN_EPI) { if (wr == 0) PG8_BAR; }
    PG8_BAR;
    if constexpr (Epi::AFTER_DRAIN) { E.fused(acc, cur, wr, wc, fr, fq, lds, wid, lane); S.done(cur); }
#undef PG8_SA
#undef PG8_SB
#undef PG8_STAGE
#undef PG8_LDA
#undef PG8_LDB
#undef PG8_MMA
#undef PG8_WAIT_V
#undef PG8_WAIT_L
#undef PG8_BAR
#undef PG8_SCHED
}
}
#define LAS __attribute__((address_space(3)))
typedef unsigned short bf16;
typedef float f32x4 __attribute__((ext_vector_type(4)));
typedef float f32x2 __attribute__((ext_vector_type(2)));
typedef unsigned u32x4 __attribute__((ext_vector_type(4)));
typedef unsigned u32x2 __attribute__((ext_vector_type(2)));
typedef short bf16x8 __attribute__((ext_vector_type(8)));
constexpr int T = 32768, SEQ = 16384, D = 1024, NIN = 11520, NP = 11776, FF = 4096, DEPTH = 4;
constexpr int NWAVES = 8, NTHREADS = 512;
constexpr int LDS_BYTES = 163840;
constexpr float EPS = 1e-6f;
constexpr size_t MiB = 1u << 20;
constexpr size_t WS_WIN = 1 * MiB, WS_WOUT = 24 * MiB, WS_W1 = 26 * MiB, WS_W2 = 34 * MiB, WS_HN = 42 * MiB, WS_VF = 106 * MiB;
constexpr size_t WS_E1 = 170 * MiB, WS_E2 = 234 * MiB, WS_E3 = 298 * MiB, WS_E4 = 362 * MiB, WS_E5 = 426 * MiB, WS_R = 490 * MiB, WS_K = 554 * MiB, WS_V = 618 * MiB;
constexpr size_t WS_XS = 682 * MiB, WS_HV = 698 * MiB, WS_AGA = 700 * MiB, WS_AGH = 702 * MiB, WS_CAR = 704 * MiB, WS_END = 706 * MiB;
constexpr size_t WS_WOUT_B = 706 * MiB, WS_W1_B = 708 * MiB, WS_END2 = 716 * MiB;
constexpr size_t WS_HID = WS_E1;

struct Args { const float* in[31]; float* out; unsigned char* ws; };
enum { I_X = 0, I_N1G, I_WIN, I_MB, I_CAW, I_LCW, I_LCB, I_LWA, I_LBA, I_LWI, I_LBI, I_LAP, I_MU, I_W0, I_W2, I_A0, I_A2, I_G2, I_KK, I_KA, I_RK, I_LNG, I_LNB, I_V0, I_V1, I_V2, I_WOUT, I_N2G, I_MW1, I_MW2, I_FG };

typedef __bf16 hwbf16x2 __attribute__((ext_vector_type(2)));
__device__ __forceinline__ unsigned pk2(float lo, float hi) { const f32x2 v = {lo, hi}; return __builtin_bit_cast(unsigned, __builtin_convertvector(v, hwbf16x2)); }
__device__ __forceinline__ unsigned f2bf(float f) { return pk2(f, 0.f) & 0xffffu; }
__device__ __forceinline__ float bf2f(unsigned short b) { return __builtin_bit_cast(float, (unsigned)b << 16); }
__device__ __forceinline__ float bflo(unsigned w) { return __builtin_bit_cast(float, w << 16); }
__device__ __forceinline__ float bfhi(unsigned w) { return __builtin_bit_cast(float, w & 0xffff0000u); }
#define LDS_WAIT() asm volatile("s_waitcnt lgkmcnt(0)" ::: "memory")
__device__ __forceinline__ float wave_sum(float v) {
#pragma unroll
    for (int o = 1; o < 64; o <<= 1) v += __shfl_xor(v, o);
    return v;
}

__device__ __forceinline__ void transpose_item(const float* W, int K, int N, int k0, int nsrc, bool zero, bf16* WT, int drow, LAS float* scr, int lane) {
    float wv_[32];
#pragma unroll
    for (int i = 0; i < 32; ++i) { const int kk = 2 * i + (lane >> 5); wv_[i] = zero ? 0.f : W[(size_t)(k0 + kk) * N + nsrc + (lane & 31)]; }
#pragma unroll
    for (int i = 0; i < 32; ++i) { const int kk = 2 * i + (lane >> 5); scr[kk * 33 + (lane & 31)] = wv_[i]; }
    LDS_WAIT();
    const int c = lane & 7;
#pragma unroll
    for (int j = 0; j < 4; ++j) { const int n = (lane >> 3) + 8 * j; const LAS float* s = scr + (8 * c) * 33 + n;
        u32x4 o; o.x = pk2(s[0 * 33], s[1 * 33]); o.y = pk2(s[2 * 33], s[3 * 33]); o.z = pk2(s[4 * 33], s[5 * 33]); o.w = pk2(s[6 * 33], s[7 * 33]);
        *(u32x4*)(WT + (size_t)(drow + n) * K + k0 + 8 * c) = o; }
    LDS_WAIT();
}
__device__ __forceinline__ int win_src_col(int nb) {
    const int t = nb >> 3, q = nb & 7, bj = q >> 2, o = (q & 3) * 32;
    if (t < 8) return (bj == 0 ? 0 : 5120) + 128 * t + o;
    if (t < 16) return (bj == 0 ? 1024 : 2048) + 128 * (t - 8) + o;
    if (t < 24) return (bj == 0 ? 4096 : 6144) + 128 * (t - 16) + o;
    if (t < 28) return 3072 + 256 * (t - 24) + 128 * bj + o;
    if (t < 32) return 7168 + 256 * (t - 28) + 128 * bj + o;
    return 8192 + 256 * (t - 32) + 128 * bj + o;
}
__device__ __forceinline__ void convert_weights(const Args& a, int l, LAS unsigned char* lds, int gw, int NGW, int wave, int lane, int part  ) {
    LAS float* scr = (LAS float*)(lds + wave * 16384);
    size_t wz_ = 0; asm volatile("" : "+s"(wz_)); unsigned char* ws = a.ws + wz_;
    constexpr int I_IN = 16 * (NP / 32), I_O = 16 * 32, I_1 = 16 * (FF / 32), I_2 = 64 * 32;
    const int it_lo = (part == 2) ? I_IN + I_O + I_1 : 0, it_hi = (part == 1) ? I_IN + I_O + I_1 : I_IN + I_O + I_1 + I_2;
    bf16* wout_t = (bf16*)(ws + ((l & 1) ? WS_WOUT_B : WS_WOUT)); bf16* w1_t = (bf16*)(ws + ((l & 1) ? WS_W1_B : WS_W1));
    for (int it = it_lo + gw; it < it_hi; it += NGW) {
        int r = it;
        if (r < I_IN) { const int kb = r / (NP / 32), nb = r % (NP / 32);
            if (nb < 360) transpose_item(a.in[I_WIN] + (size_t)l * D * NIN, D, NIN, 64 * kb, win_src_col(nb), false, (bf16*)(ws + WS_WIN), 32 * nb, scr, lane);
            else { const bool real = (nb == 360) && (l > 0); transpose_item(a.in[I_V1] + (size_t)(real ? l - 1 : 0) * D * 32, D, 32, 64 * kb, 0, !real, (bf16*)(ws + WS_WIN), 32 * nb, scr, lane); }
            continue; }
        r -= I_IN;
        if (r < I_O) { transpose_item(a.in[I_WOUT] + (size_t)l * D * D, D, D, 64 * (r / 32), 32 * (r % 32), false, wout_t, 32 * (r % 32), scr, lane); continue; }
        r -= I_O;
        if (r < I_1) { transpose_item(a.in[I_MW1] + (size_t)l * D * FF, D, FF, 64 * (r / 128), 32 * (r % 128), false, w1_t, 32 * (r % 128), scr, lane); continue; }
        r -= I_1;
        transpose_item(a.in[I_MW2] + (size_t)l * FF * D, FF, D, 64 * (r / 32), 32 * (r % 32), false, (bf16*)(ws + WS_W2), 32 * (r % 32), scr, lane);
    }
}
__device__ __forceinline__ void rms_row_bf16(const float* xrow, const float* g, bf16* orow, int lane) {
    const f32x4* xr = (const f32x4*)xrow + lane; f32x4 v[4]; float s = 0.f;
#pragma unroll
    for (int j = 0; j < 4; ++j) { v[j] = xr[64 * j]; s += (v[j].x * v[j].x + v[j].y * v[j].y) + (v[j].z * v[j].z + v[j].w * v[j].w); }
    const float rstd = rsqrtf(wave_sum(s) * (1.f / D) + EPS);
    u32x2* o8 = (u32x2*)orow + lane;
#pragma unroll
    for (int j = 0; j < 4; ++j) { const f32x4 gv = ((const f32x4*)g)[lane + 64 * j]; u32x2 w; w.x = pk2(v[j].x * rstd * gv.x, v[j].y * rstd * gv.y); w.y = pk2(v[j].z * rstd * gv.z, v[j].w * rstd * gv.w); o8[64 * j] = w; }
}
__device__ __forceinline__ void rms_rows_bf16(const float* x, const float* g, bf16* out, int gw, int NGW, int lane) {
    f32x4 gv[4], nv[4];
#pragma unroll
    for (int j = 0; j < 4; ++j) gv[j] = ((const f32x4*)g)[lane + 64 * j];
    if (gw < T) {
#pragma unroll
        for (int j = 0; j < 4; ++j) nv[j] = ((const f32x4*)(x + (size_t)gw * D))[lane + 64 * j];
    }
    for (int m = gw; m < T; m += NGW) {
        f32x4 v[4]; float s = 0.f;
#pragma unroll
        for (int j = 0; j < 4; ++j) { v[j] = nv[j]; s += (v[j].x * v[j].x + v[j].y * v[j].y) + (v[j].z * v[j].z + v[j].w * v[j].w); }
        const int mn = (m + NGW < T) ? m + NGW : m;
#pragma unroll
        for (int j = 0; j < 4; ++j) nv[j] = ((const f32x4*)(x + (size_t)mn * D))[lane + 64 * j];
        const float rstd = rsqrtf(wave_sum(s) * (1.f / D) + EPS);
        u32x2* o8 = (u32x2*)(out + (size_t)m * D) + lane;
#pragma unroll
        for (int j = 0; j < 4; ++j) { u32x2 w; w.x = pk2(v[j].x * rstd * gv[j].x, v[j].y * rstd * gv[j].y); w.y = pk2(v[j].z * rstd * gv[j].z, v[j].w * rstd * gv[j].w); o8[64 * j] = w; }
    }
}
__device__ __forceinline__ void rms_rows_f32(float* x, const float* g, int gw, int NGW, int lane) {
    f32x4 gv[4], nv[4];
#pragma unroll
    for (int j = 0; j < 4; ++j) gv[j] = ((const f32x4*)g)[lane + 64 * j];
    if (gw < T) {
#pragma unroll
        for (int j = 0; j < 4; ++j) nv[j] = ((const f32x4*)(x + (size_t)gw * D))[lane + 64 * j];
    }
    for (int m = gw; m < T; m += NGW) {
        f32x4 v[4]; float s = 0.f;
#pragma unroll
        for (int j = 0; j < 4; ++j) { v[j] = nv[j]; s += (v[j].x * v[j].x + v[j].y * v[j].y) + (v[j].z * v[j].z + v[j].w * v[j].w); }
        if (m + NGW < T) {
#pragma unroll
            for (int j = 0; j < 4; ++j) nv[j] = ((const f32x4*)(x + (size_t)(m + NGW) * D))[lane + 64 * j];
        }
        const float rstd = rsqrtf(wave_sum(s) * (1.f / D) + EPS);
        f32x4* xr = (f32x4*)(x + (size_t)m * D) + lane;
#pragma unroll
        for (int j = 0; j < 4; ++j) xr[64 * j] = v[j] * rstd * gv[j];
    }
}
__device__ __forceinline__ void rms_row_f32(float* xrow, const float* g, int lane) {
    f32x4* xr = (f32x4*)xrow + lane; f32x4 v[4]; float s = 0.f;
#pragma unroll
    for (int j = 0; j < 4; ++j) { v[j] = xr[64 * j]; s += (v[j].x * v[j].x + v[j].y * v[j].y) + (v[j].z * v[j].z + v[j].w * v[j].w); }
    const float rstd = rsqrtf(wave_sum(s) * (1.f / D) + EPS);
#pragma unroll
    for (int j = 0; j < 4; ++j) { const f32x4 gv = ((const f32x4*)g)[lane + 64 * j]; xr[64 * j] = v[j] * rstd * gv; }
}

__device__ __forceinline__ float fsig(float x) { return __builtin_amdgcn_rcpf(1.0f + __expf(-x)); }
__device__ __forceinline__ void ld8bf(const bf16* p, float (&o)[8]) { const u32x4 w = *(const u32x4*)p; o[0] = bflo(w.x); o[1] = bfhi(w.x); o[2] = bflo(w.y); o[3] = bfhi(w.y); o[4] = bflo(w.z); o[5] = bfhi(w.z); o[6] = bflo(w.w); o[7] = bfhi(w.w); }
__device__ __forceinline__ void un8(const u32x4 w, float (&o)[8]) { o[0] = bflo(w.x); o[1] = bfhi(w.x); o[2] = bflo(w.y); o[3] = bfhi(w.y); o[4] = bflo(w.z); o[5] = bfhi(w.z); o[6] = bflo(w.w); o[7] = bfhi(w.w); }
__device__ __forceinline__ void ld8f(const float* p, float (&o)[8]) { const f32x4 a = *(const f32x4*)p, b = *(const f32x4*)(p + 4); o[0] = a.x; o[1] = a.y; o[2] = a.z; o[3] = a.w; o[4] = b.x; o[5] = b.y; o[6] = b.z; o[7] = b.w; }
__device__ __forceinline__ u32x4 pk8(const float (&v)[8]) { u32x4 w; w.x = pk2(v[0], v[1]); w.y = pk2(v[2], v[3]); w.z = pk2(v[4], v[5]); w.w = pk2(v[6], v[7]); return w; }
__device__ __forceinline__ bf16x8 frag_from_f32(const float* p, int stride) {
    u32x4 w; w.x = pk2(p[0], p[stride]); w.y = pk2(p[2 * stride], p[3 * stride]); w.z = pk2(p[4 * stride], p[5 * stride]); w.w = pk2(p[6 * stride], p[7 * stride]);
    return __builtin_bit_cast(bf16x8, w);
}
template <int CTRL> __device__ __forceinline__ float dpp_f(float x) { return __builtin_bit_cast(float, __builtin_amdgcn_update_dpp(0, __builtin_bit_cast(int, x), CTRL, 0xf, 0xf, true)); }
__device__ __forceinline__ float red8(float x) {
    x += dpp_f<0xB1>(x);
    x += dpp_f<0x4E>(x);
    x += dpp_f<0x141>(x);
    return x;
}

template <bool PASS3>
__device__ __forceinline__ void lru_phase(const Args& a, int l, LAS unsigned char* lds, int gw, int NGW, int wave, int lane) {
    LAS unsigned char* wl = lds + wave * 16384;
    LAS bf16* Ubf = (LAS bf16*)wl; LAS float* Uf = (LAS float*)(wl + 2304); LAS float* Ab = (LAS float*)(wl + 6528); LAS float* Hb = (LAS float*)(wl + 10752);
    size_t wz_ = 0; asm volatile("" : "+s"(wz_)); unsigned char* ws = a.ws + wz_;
    const bf16* XB = (const bf16*)(ws + WS_E3);
    float* AGA = (float*)(ws + WS_AGA); float* AGH = (float*)(ws + WS_AGH); const float* CAR = (const float*)(ws + WS_CAR);
    const float* cw = a.in[I_LCW] + (size_t)l * 4 * D; const float* cbp = a.in[I_LCB] + (size_t)l * D;
    const int fr = lane & 15, fq = lane >> 4;
    int cur_hh = -1;
    bf16x8 wfa[2][4], wfi[2][4];
    float ba_[4], bi_[4], sp_[4];
    float cw0 = 0.f, cw1 = 0.f, cw2 = 0.f, cw3 = 0.f, cbv = 0.f;
    for (int u = gw; u < 8192; u += NGW) {
        const int hh = u & 15, cidx = u >> 4, chunk = cidx & 255, b = cidx >> 8;
        const int ch0 = hh * 64; const size_t row0 = (size_t)b * SEQ + (size_t)chunk * 64;
        if (hh != cur_hh) {
            cur_hh = hh;
            const float* wa = a.in[I_LWA] + ((size_t)l * 16 + hh) * 4096; const float* wi = a.in[I_LWI] + ((size_t)l * 16 + hh) * 4096;
#pragma unroll
            for (int ks = 0; ks < 2; ++ks)
#pragma unroll
                for (int nt = 0; nt < 4; ++nt) { const int off = (32 * ks + 8 * fq) * 64 + 16 * nt + fr; wfa[ks][nt] = frag_from_f32(wa + off, 64); wfi[ks][nt] = frag_from_f32(wi + off, 64); }
#pragma unroll
            for (int nt = 0; nt < 4; ++nt) { const int c = l * D + ch0 + 16 * nt + fr; ba_[nt] = a.in[I_LBA][c]; bi_[nt] = a.in[I_LBI][c]; sp_[nt] = log1pf(expf(a.in[I_LAP][c])); }
            const int c = ch0 + lane; cw0 = cw[c]; cw1 = cw[D + c]; cw2 = cw[2 * D + c]; cw3 = cw[3 * D + c]; cbv = cbp[c];
        }
        const float hm = (chunk > 0) ? 1.0f : 0.0f; const size_t hrow = (chunk > 0) ? row0 - 3 : row0;
        float xm3, xm2, xm1;
        { const bf16* p = XB + hrow * D + ch0 + lane; const unsigned short h0 = p[0], h1 = p[D], h2 = p[2 * D]; xm3 = bf2f(h0) * hm; xm2 = bf2f(h1) * hm; xm1 = bf2f(h2) * hm; }
        float hc = 0.f, ap = 1.f;
        if (PASS3) hc = CAR[(size_t)cidx * D + ch0 + lane];
        unsigned short xn[16];
#pragma unroll
        for (int t = 0; t < 16; ++t) xn[t] = XB[(row0 + t) * D + ch0 + lane];
        for (int mt = 0; mt < 4; ++mt) {
            const size_t r0 = row0 + mt * 16;
            float xv[16];
#pragma unroll
            for (int t = 0; t < 16; ++t) xv[t] = bf2f(xn[t]);
            { const size_t rn = row0 + ((mt < 3) ? mt + 1 : 3) * 16;
#pragma unroll
              for (int t = 0; t < 16; ++t) xn[t] = XB[(rn + t) * D + ch0 + lane]; }
            const int ct = lane >> 2, cq = lane & 3, cc = ch0 + cq * 16; const size_t cr = r0 + ct; const int tseq = chunk * 64 + mt * 16 + ct;
            u32x4 qza[2], qzb[2], qx2[2], qx1[2], qx0[2];
            if (PASS3) {
                const bf16* E1p = (const bf16*)(ws + WS_E1) + cr * D + cc; const bf16* E2p = (const bf16*)(ws + WS_E2) + cr * D + cc; const bf16* E4p = (const bf16*)(ws + WS_E4) + cr * D + cc;
                const bf16* E2p1 = E2p - ((tseq >= 1) ? D : 0); const bf16* E2p0 = E2p - ((tseq >= 2) ? 2 * D : 0);
#pragma unroll
                for (int h8 = 0; h8 < 2; ++h8) { qza[h8] = *(const u32x4*)(E1p + 8 * h8); qzb[h8] = *(const u32x4*)(E4p + 8 * h8); qx2[h8] = *(const u32x4*)(E2p + 8 * h8); qx1[h8] = *(const u32x4*)(E2p1 + 8 * h8); qx0[h8] = *(const u32x4*)(E2p0 + 8 * h8); }
            }
#pragma unroll
            for (int t = 0; t < 16; ++t) { const float uu = cbv + cw0 * xm3 + cw1 * xm2 + cw2 * xm1 + cw3 * xv[t]; xm3 = xm2; xm2 = xm1; xm1 = xv[t]; Ubf[t * 72 + lane] = (bf16)f2bf(uu); Uf[t * 66 + lane] = uu; }
            LDS_WAIT();
            bf16x8 af[2];
#pragma unroll
            for (int ks = 0; ks < 2; ++ks) af[ks] = *(const LAS bf16x8*)(Ubf + fr * 72 + 32 * ks + 8 * fq);
            f32x4 ca[4], ci[4];
#pragma unroll
            for (int nt = 0; nt < 4; ++nt) { ca[nt] = (f32x4){0.f, 0.f, 0.f, 0.f}; ci[nt] = ca[nt];
#pragma unroll
                for (int ks = 0; ks < 2; ++ks) { ca[nt] = __builtin_amdgcn_mfma_f32_16x16x32_bf16(af[ks], wfa[ks][nt], ca[nt], 0, 0, 0); ci[nt] = __builtin_amdgcn_mfma_f32_16x16x32_bf16(af[ks], wfi[ks][nt], ci[nt], 0, 0, 0); } }
#pragma unroll
            for (int nt = 0; nt < 4; ++nt)
#pragma unroll
                for (int rg = 0; rg < 4; ++rg) { const int tok = 4 * fq + rg, c = 16 * nt + fr;
                    const float ga = fsig(ca[nt][rg] + ba_[nt]), gi = fsig(ci[nt][rg] + bi_[nt]);
                    const float la = -8.0f * ga * sp_[nt]; const float av = __expf(la); float mult = __builtin_amdgcn_sqrtf(fmaxf(1.0f - av * av, 0.f));
                    if (chunk == 0 && mt == 0 && tok == 0) mult = 1.0f;
                    Ab[tok * 66 + c] = av; Hb[tok * 66 + c] = Uf[tok * 66 + c] * gi * mult; }
            LDS_WAIT();
#pragma unroll
            for (int t = 0; t < 16; ++t) { const float av = Ab[t * 66 + lane], uu = Hb[t * 66 + lane]; hc = av * hc + uu; ap *= av; if (PASS3) Hb[t * 66 + lane] = hc; }
            if (PASS3) {
                LDS_WAIT();
                bf16* Mp = (bf16*)(ws + WS_HN) + cr * D + cc; const float* caw = a.in[I_CAW] + (size_t)l * 3 * D + cc;
                const float m1 = (tseq >= 1) ? 1.0f : 0.0f, m0 = (tseq >= 2) ? 1.0f : 0.0f;
#pragma unroll
                for (int h8 = 0; h8 < 2; ++h8) {
                    float za[8], zb[8], x0[8], x1[8], x2[8], w0[8], w1[8], w2[8], o[8];
                    un8(qza[h8], za); un8(qzb[h8], zb); un8(qx2[h8], x2); un8(qx1[h8], x1); un8(qx0[h8], x0);
                    ld8f(caw + 8 * h8, w0); ld8f(caw + D + 8 * h8, w1); ld8f(caw + 2 * D + 8 * h8, w2);
#pragma unroll
                    for (int i = 0; i < 8; ++i) { const float hv = Hb[ct * 66 + cq * 16 + 8 * h8 + i]; o[i] = za[i] * (w0[i] * m0 * x0[i] + w1[i] * m1 * x1[i] + w2[i] * x2[i]) + zb[i] * hv; }
                    *(u32x4*)(Mp + 8 * h8) = pk8(o);
                }
            }
            LDS_WAIT();
        }
        if (!PASS3) { AGA[(size_t)cidx * D + ch0 + lane] = ap; AGH[(size_t)cidx * D + ch0 + lane] = hc; }
    }
}
__device__ __forceinline__ void lru_carry_phase(const Args& a, LAS unsigned char* lds, int wave, int lane) {
    if (blockIdx.x >= 32) return;
    const int b = blockIdx.x >> 4, c = (blockIdx.x & 15) * 64 + lane;
    size_t wz_ = 0; asm volatile("" : "+s"(wz_)); unsigned char* ws = a.ws + wz_;
    const float* AGA = (const float*)(ws + WS_AGA) + ((size_t)b * 256 + 32 * wave) * D + c; const float* AGH = (const float*)(ws + WS_AGH) + ((size_t)b * 256 + 32 * wave) * D + c;
    float* CAR = (float*)(ws + WS_CAR) + ((size_t)b * 256 + 32 * wave) * D + c;
    LAS float* SA = (LAS float*)lds; LAS float* SH = SA + 512;
    float av[32], hv[32];
#pragma unroll
    for (int i = 0; i < 32; ++i) { av[i] = AGA[(size_t)i * D]; hv[i] = AGH[(size_t)i * D]; }
    float pa = 1.f, ph = 0.f;
#pragma unroll
    for (int i = 0; i < 32; ++i) { const float a_ = av[i], h_ = hv[i]; av[i] = pa; hv[i] = ph; ph = a_ * ph + h_; pa *= a_; }
    SA[wave * 64 + lane] = pa; SH[wave * 64 + lane] = ph;
    __syncthreads();
    float cin = 0.f;
    for (int s = 0; s < wave; ++s) cin = SA[s * 64 + lane] * cin + SH[s * 64 + lane];
#pragma unroll
    for (int i = 0; i < 32; ++i) CAR[(size_t)i * D] = av[i] * cin + hv[i];
}

constexpr int RST = 68, RARR = 64 * RST * 4;
__device__ __forceinline__ void rwkv_naive_phase(const Args& a, int l, LAS unsigned char* lds, int tid, int wave, int lane) {
    if (blockIdx.x >= 32) return;
    const int b = blockIdx.x >> 4, hd = blockIdx.x & 15;
    size_t wz_ = 0; asm volatile("" : "+s"(wz_)); unsigned char* ws = a.ws + wz_;
    LAS float* PW = (LAS float*)(lds + 0 * RARR); LAS float* PA = (LAS float*)(lds + 1 * RARR); LAS float* PV = (LAS float*)(lds + 2 * RARR); LAS float* PG = (LAS float*)(lds + 3 * RARR);
    LAS float* RR = (LAS float*)(lds + 4 * RARR); LAS float* KK = (LAS float*)(lds + 5 * RARR); LAS float* KN = (LAS float*)(lds + 6 * RARR); LAS float* YY = (LAS float*)(lds + 7 * RARR);
    LAS float* RKC = (LAS float*)(lds + 8 * RARR);
    LAS bf16* AW = (LAS bf16*)(lds + 4 * RARR); LAS bf16* AA = AW + 64 * 72; LAS bf16* AG = AA + 64 * 72; LAS bf16* AV = AG + 64 * 136;
    const bf16* XS = (const bf16*)(ws + WS_XS); const bf16* HV = (const bf16*)(ws + WS_HV);
    const bf16* Rg = (const bf16*)(ws + WS_R); const bf16* Kg = (const bf16*)(ws + WS_K); const bf16* Vg = (const bf16*)(ws + WS_V);
    bf16* VF = (bf16*)(ws + WS_VF); const bf16* E5 = (const bf16*)(ws + WS_E5); bf16* HN = (bf16*)(ws + WS_HN);
    const int fr = lane & 15, fq = lane >> 4, nt = wave & 3, mh = wave >> 2;
    const int colw = hd * 64 + 16 * nt + fr;
    bf16x8 fw[2], fa[2], fg[4], fv;
#pragma unroll
    for (int ks = 0; ks < 2; ++ks) { fw[ks] = frag_from_f32(a.in[I_W2] + ((size_t)l * 64 + 32 * ks + 8 * fq) * D + colw, D); fa[ks] = frag_from_f32(a.in[I_A2] + ((size_t)l * 64 + 32 * ks + 8 * fq) * D + colw, D); }
#pragma unroll
    for (int ks = 0; ks < 4; ++ks) fg[ks] = frag_from_f32(a.in[I_G2] + ((size_t)l * 128 + 32 * ks + 8 * fq) * D + colw, D);
    fv = fw[0];
    if (l > 0) fv = frag_from_f32(a.in[I_V2] + ((size_t)(l - 1) * 32 + 8 * fq) * D + colw, D);
    const float w0c = a.in[I_W0][l * D + colw], a0c = a.in[I_A0][l * D + colw], v0c = (l > 0) ? a.in[I_V0][(l - 1) * D + colw] : 0.f;
    const int t = tid >> 3, cg8 = tid & 7, c0 = hd * 64 + 8 * cg8;
    const float* mu = a.in[I_MU] + (size_t)l * 3328;
    float S[8];
#pragma unroll
    for (int i = 0; i < 8; ++i) S[i] = 0.f;
    const int vrow = 8 * wave + (lane >> 3), ks8 = lane & 7;
    for (int chunk = 0; chunk < 256; ++chunk) {
        const size_t row = (size_t)b * SEQ + (size_t)chunk * 64 + t;
        const bool hasprev = (chunk > 0) || (t > 0);
        {
            const bf16* xs = XS + row * 256; const float* mx = mu + 3072;
            float c[8], p[8], m[8], o[8];
            ld8bf(xs + 8 * cg8, c); if (hasprev) ld8bf(xs - 256 + 8 * cg8, p); else {
#pragma unroll
                for (int i = 0; i < 8; ++i) p[i] = 0.f; }
            ld8f(mx + 8 * cg8, m);
#pragma unroll
            for (int i = 0; i < 8; ++i) { const float s = c[i] + (p[i] - c[i]) * m[i]; o[i] = 2.0f * fsig(2.0f * s) - 1.0f; }
            *(LAS u32x4*)(AW + t * 72 + 8 * cg8) = pk8(o);
            ld8bf(xs + 64 + 8 * cg8, c); if (hasprev) ld8bf(xs - 256 + 64 + 8 * cg8, p);
            ld8f(mx + 64 + 8 * cg8, m);
#pragma unroll
            for (int i = 0; i < 8; ++i) o[i] = c[i] + (p[i] - c[i]) * m[i];
            *(LAS u32x4*)(AA + t * 72 + 8 * cg8) = pk8(o);
#pragma unroll
            for (int h8 = 0; h8 < 2; ++h8) {
                ld8bf(xs + 128 + 16 * cg8 + 8 * h8, c); if (hasprev) ld8bf(xs - 256 + 128 + 16 * cg8 + 8 * h8, p);
                ld8f(mx + 128 + 16 * cg8 + 8 * h8, m);
#pragma unroll
                for (int i = 0; i < 8; ++i) o[i] = fsig(c[i] + (p[i] - c[i]) * m[i]);
                *(LAS u32x4*)(AG + t * 136 + 16 * cg8 + 8 * h8) = pk8(o);
            }
            *(LAS u32x2*)(AV + t * 40 + 4 * cg8) = *(const u32x2*)(HV + row * 32 + 4 * cg8);
        }
        __syncthreads();
#pragma unroll
        for (int mi = 0; mi < 2; ++mi) {
            const int m = 2 * mh + mi;
            f32x4 cw = (f32x4){0.f, 0.f, 0.f, 0.f}, ca = cw, cgg = cw, cv = cw;
#pragma unroll
            for (int ks = 0; ks < 2; ++ks) { cw = __builtin_amdgcn_mfma_f32_16x16x32_bf16(*(const LAS bf16x8*)(AW + (16 * m + fr) * 72 + 32 * ks + 8 * fq), fw[ks], cw, 0, 0, 0);
                                              ca = __builtin_amdgcn_mfma_f32_16x16x32_bf16(*(const LAS bf16x8*)(AA + (16 * m + fr) * 72 + 32 * ks + 8 * fq), fa[ks], ca, 0, 0, 0); }
#pragma unroll
            for (int ks = 0; ks < 4; ++ks) cgg = __builtin_amdgcn_mfma_f32_16x16x32_bf16(*(const LAS bf16x8*)(AG + (16 * m + fr) * 136 + 32 * ks + 8 * fq), fg[ks], cgg, 0, 0, 0);
            if (l > 0) cv = __builtin_amdgcn_mfma_f32_16x16x32_bf16(*(const LAS bf16x8*)(AV + (16 * m + fr) * 40 + 8 * fq), fv, cv, 0, 0, 0);
#pragma unroll
            for (int rg = 0; rg < 4; ++rg) { const int o = (16 * m + 4 * fq + rg) * RST + 16 * nt + fr;
                PW[o] = expf(-0.6065306597f * fsig(w0c + cw[rg])); PA[o] = fsig(a0c + ca[rg]); PG[o] = cgg[rg]; PV[o] = fsig(v0c + cv[rg]); }
        }
        __syncthreads();
        {
            float r[8], k[8], v[8], p[8], m[8];
            ld8bf(Rg + row * D + c0, r); if (hasprev) ld8bf(Rg + (row - 1) * D + c0, p); else {
#pragma unroll
                for (int i = 0; i < 8; ++i) p[i] = 0.f; }
            ld8f(mu + c0, m);
#pragma unroll
            for (int i = 0; i < 8; ++i) r[i] += (p[i] - r[i]) * m[i];
            ld8bf(Kg + row * D + c0, k); if (hasprev) ld8bf(Kg + (row - 1) * D + c0, p);
            ld8f(mu + 1024 + c0, m);
#pragma unroll
            for (int i = 0; i < 8; ++i) k[i] += (p[i] - k[i]) * m[i];
            ld8bf(Vg + row * D + c0, v); if (hasprev) ld8bf(Vg + (row - 1) * D + c0, p);
            ld8f(mu + 2048 + c0, m);
#pragma unroll
            for (int i = 0; i < 8; ++i) v[i] += (p[i] - v[i]) * m[i];
            if (l == 0) *(u32x4*)(VF + row * D + c0) = pk8(v);
            else { float vf[8]; ld8bf(VF + row * D + c0, vf);
#pragma unroll
                for (int i = 0; i < 8; ++i) v[i] += (vf[i] - v[i]) * PV[t * RST + 8 * cg8 + i]; }
            float kkc[8], kac[8], rkk[8], av[8], kn[8];
            ld8f(a.in[I_KK] + l * D + c0, kkc); ld8f(a.in[I_KA] + l * D + c0, kac); ld8f(a.in[I_RK] + l * D + c0, rkk);
            float ss = 0.f, bon = 0.f;
#pragma unroll
            for (int i = 0; i < 8; ++i) { av[i] = PA[t * RST + 8 * cg8 + i]; kn[i] = k[i] * kkc[i]; ss += kn[i] * kn[i]; k[i] = k[i] * (1.0f + (av[i] - 1.0f) * kac[i]); bon += r[i] * k[i] * rkk[i]; }
            ss = red8(ss); bon = red8(bon);
            const float inv = 1.0f / fmaxf(sqrtf(ss), 1e-12f);
            if (cg8 == 0) RKC[t] = bon;
#pragma unroll
            for (int i = 0; i < 8; ++i) { const int o = t * RST + 8 * cg8 + i; kn[i] *= inv; RR[o] = r[i]; KK[o] = k[i]; KN[o] = kn[i]; PA[o] = kn[i] * av[i]; PV[o] = v[i]; }
        }
        __syncthreads();
#pragma unroll 2
        for (int s = 0; s < 64; ++s) {
            const f32x4 n0 = *(const LAS f32x4*)(KN + s * RST + 8 * ks8), n1 = *(const LAS f32x4*)(KN + s * RST + 8 * ks8 + 4);
            const f32x4 d0 = *(const LAS f32x4*)(PW + s * RST + 8 * ks8), d1 = *(const LAS f32x4*)(PW + s * RST + 8 * ks8 + 4);
            const f32x4 b0 = *(const LAS f32x4*)(PA + s * RST + 8 * ks8), b1 = *(const LAS f32x4*)(PA + s * RST + 8 * ks8 + 4);
            const f32x4 k0 = *(const LAS f32x4*)(KK + s * RST + 8 * ks8), k1 = *(const LAS f32x4*)(KK + s * RST + 8 * ks8 + 4);
            const f32x4 r0 = *(const LAS f32x4*)(RR + s * RST + 8 * ks8), r1 = *(const LAS f32x4*)(RR + s * RST + 8 * ks8 + 4);
            const float vv = PV[s * RST + vrow];
            float sa = (S[0] * n0.x + S[1] * n0.y) + (S[2] * n0.z + S[3] * n0.w) + (S[4] * n1.x + S[5] * n1.y) + (S[6] * n1.z + S[7] * n1.w);
            sa = -red8(sa);
            S[0] = S[0] * d0.x + sa * b0.x + vv * k0.x; S[1] = S[1] * d0.y + sa * b0.y + vv * k0.y; S[2] = S[2] * d0.z + sa * b0.z + vv * k0.z; S[3] = S[3] * d0.w + sa * b0.w + vv * k0.w;
            S[4] = S[4] * d1.x + sa * b1.x + vv * k1.x; S[5] = S[5] * d1.y + sa * b1.y + vv * k1.y; S[6] = S[6] * d1.z + sa * b1.z + vv * k1.z; S[7] = S[7] * d1.w + sa * b1.w + vv * k1.w;
            float y = (S[0] * r0.x + S[1] * r0.y) + (S[2] * r0.z + S[3] * r0.w) + (S[4] * r1.x + S[5] * r1.y) + (S[6] * r1.z + S[7] * r1.w);
            y = red8(y);
            if (ks8 == 0) YY[s * RST + vrow] = y;
        }
        __syncthreads();
        {
            float y[8], lg[8], lb[8], zc[8], hn[8], o[8];
            float sm = 0.f;
#pragma unroll
            for (int i = 0; i < 8; ++i) { y[i] = YY[t * RST + 8 * cg8 + i]; sm += y[i]; }
            const float mean = red8(sm) * (1.0f / 64.0f); float q = 0.f;
#pragma unroll
            for (int i = 0; i < 8; ++i) { y[i] -= mean; q += y[i] * y[i]; }
            const float rs = rsqrtf(red8(q) * (1.0f / 64.0f) + 64.0f * 1e-5f);
            ld8f(a.in[I_LNG] + l * D + c0, lg); ld8f(a.in[I_LNB] + l * D + c0, lb); ld8bf(E5 + row * D + c0, zc); ld8bf(HN + row * D + c0, hn);
            const float bon = RKC[t];
#pragma unroll
            for (int i = 0; i < 8; ++i) { const int oo = t * RST + 8 * cg8 + i; o[i] = hn[i] + ((y[i] * rs * lg[i] + lb[i]) + bon * PV[oo]) * PG[oo] * zc[i]; }
            *(u32x4*)(HN + row * D + c0) = pk8(o);
        }
        __syncthreads();
    }
}
typedef short bf16x4 __attribute__((ext_vector_type(4)));
__device__ __forceinline__ bf16x4 pk4(const f32x4 v) { u32x2 w; w.x = pk2(v[0], v[1]); w.y = pk2(v[2], v[3]); return __builtin_bit_cast(bf16x4, w); }
__device__ __forceinline__ f32x4 mfma16(bf16x4 a, bf16x4 b, f32x4 c) { return __builtin_amdgcn_mfma_f32_16x16x16bf16_1k(a, b, c, 0, 0, 0); }
__device__ __forceinline__ f32x4 mfma32(bf16x8 a, bf16x8 b, f32x4 c) { return __builtin_amdgcn_mfma_f32_16x16x32_bf16(a, b, c, 0, 0, 0); }
#define LDF8(p) (*(const LAS bf16x8*)(p))
#define BAR_LDS() do { asm volatile("s_waitcnt lgkmcnt(0)" ::: "memory"); __builtin_amdgcn_s_barrier(); asm volatile("" ::: "memory"); } while (0)
constexpr int TS = 72;
constexpr int TILE_B = 64 * TS * 2;
constexpr int XR_F32 = 0;
constexpr int XR_T = 4 * RARR;
constexpr int XR_SEG = XR_T + 7 * TILE_B;

__device__ __forceinline__ void rwkv_x1_phase(const Args& a, int l, LAS unsigned char* lds, int tid, int wave, int lane_unused) {
    size_t wz_ = 0; asm volatile("" : "+s"(wz_)); unsigned char* ws = a.ws + wz_;
    LAS float* LW = (LAS float*)(lds + XR_F32 + 0 * RARR); LAS float* PA = (LAS float*)(lds + XR_F32 + 1 * RARR); LAS float* PV = (LAS float*)(lds + XR_F32 + 2 * RARR); LAS float* PG = (LAS float*)(lds + XR_F32 + 3 * RARR);
    LAS bf16* Mab = (LAS bf16*)(lds + XR_F32); LAS bf16* Mak = Mab + 64 * TS; LAS bf16* Mrb = Mak + 64 * TS; LAS bf16* Mrk = Mrb + 64 * TS; LAS bf16* Xt = Mrk + 64 * TS;
    LAS bf16* At = (LAS bf16*)(lds + XR_T); LAS bf16* Rt = At + 64 * TS; LAS bf16* Bt = Rt + 64 * TS; LAS bf16* Kt = Bt + 64 * TS; LAS bf16* BhT = Kt + 64 * TS; LAS bf16* KhT = BhT + 64 * TS; LAS bf16* Vt = KhT + 64 * TS;
    LAS bf16* AW = (LAS bf16*)(lds + XR_T); LAS bf16* AA = AW + 64 * 72; LAS bf16* AG = AA + 64 * 72; LAS bf16* AV = AG + 64 * 136;
    LAS float* SEG = (LAS float*)(lds + XR_SEG); LAS bf16* TTl = (LAS bf16*)(lds + XR_SEG);
    const bf16* XS = (const bf16*)(ws + WS_XS); const bf16* HV = (const bf16*)(ws + WS_HV);
    const bf16* Rg = (const bf16*)(ws + WS_R); const bf16* Kg = (const bf16*)(ws + WS_K); const bf16* Vg = (const bf16*)(ws + WS_V);
    bf16* VF = (bf16*)(ws + WS_VF); bf16* E5 = (bf16*)(ws + WS_E5); bf16* HN = (bf16*)(ws + WS_HN);
    bf16* Qg = (bf16*)(ws + WS_E1); bf16* Y0g = (bf16*)(ws + WS_E2); bf16* Ptg = (bf16*)(ws + WS_E3); bf16* Hg = (bf16*)(ws + WS_E4); float* gCg = (float*)(ws + WS_AGA);
    const int nt = wave & 3, mh = wave >> 2;
    const float* mu = a.in[I_MU] + (size_t)l * 3328;
    int cur_bh = -1;
    bf16x8 fw[2], fa[2], fg[4], fv;
    float w0c = 0.f, a0c = 0.f, v0c = 0.f;
    u32x4 n_wc, n_wp, n_ac, n_ap, n_g0c, n_g0p, n_g1c, n_g1p; u32x2 n_hv;
#define X1_PF(u_, tt_) do { const int bh_ = (u_) & 31, ch_ = (u_) >> 5, t_ = (tt_) >> 3, c8_ = (tt_) & 7; \
        const size_t row_ = (size_t)(bh_ >> 4) * SEQ + (size_t)ch_ * 64 + t_; const size_t prow_ = (ch_ > 0 || t_ > 0) ? row_ - 1 : row_; \
        const bf16* xs_ = XS + row_ * 256; const bf16* xp_ = XS + prow_ * 256; \
        n_wc = *(const u32x4*)(xs_ + 8 * c8_); n_wp = *(const u32x4*)(xp_ + 8 * c8_); n_ac = *(const u32x4*)(xs_ + 64 + 8 * c8_); n_ap = *(const u32x4*)(xp_ + 64 + 8 * c8_); \
        n_g0c = *(const u32x4*)(xs_ + 128 + 16 * c8_); n_g0p = *(const u32x4*)(xp_ + 128 + 16 * c8_); n_g1c = *(const u32x4*)(xs_ + 136 + 16 * c8_); n_g1p = *(const u32x4*)(xp_ + 136 + 16 * c8_); \
        n_hv = *(const u32x2*)(HV + row_ * 32 + 4 * c8_); } while (0)
    if ((int)blockIdx.x < 8192) X1_PF((int)blockIdx.x, tid);
    for (int u = blockIdx.x; u < 8192; u += gridDim.x) {
        int tl_ = tid; asm volatile("" : "+v"(tl_));
        const int lane = tl_ & 63, fr = lane & 15, fq = lane >> 4, t = tl_ >> 3, cg8 = tl_ & 7;
        const int bh = u & 31, chunk = u >> 5, b = bh >> 4, hd = bh & 15;
        const size_t uidx = (size_t)chunk * 32 + bh;
        if (bh != cur_bh) {
            cur_bh = bh;
            const int colw = hd * 64 + 16 * nt + fr;
#pragma unroll
            for (int ks = 0; ks < 2; ++ks) { fw[ks] = frag_from_f32(a.in[I_W2] + ((size_t)l * 64 + 32 * ks + 8 * fq) * D + colw, D); fa[ks] = frag_from_f32(a.in[I_A2] + ((size_t)l * 64 + 32 * ks + 8 * fq) * D + colw, D); }
#pragma unroll
            for (int ks = 0; ks < 4; ++ks) fg[ks] = frag_from_f32(a.in[I_G2] + ((size_t)l * 128 + 32 * ks + 8 * fq) * D + colw, D);
            fv = fw[0];
            if (l > 0) fv = frag_from_f32(a.in[I_V2] + ((size_t)(l - 1) * 32 + 8 * fq) * D + colw, D);
            w0c = a.in[I_W0][l * D + colw]; a0c = a.in[I_A0][l * D + colw]; v0c = (l > 0) ? a.in[I_V0][(l - 1) * D + colw] : 0.f;
        }
        const int c0 = hd * 64 + 8 * cg8;
        const size_t row = (size_t)b * SEQ + (size_t)chunk * 64 + t;
        const bool hasprev = (chunk > 0) || (t > 0);
        const size_t prow = hasprev ? row - 1 : row; const float pm = hasprev ? 1.0f : 0.0f;
        const u32x4 q_rc = *(const u32x4*)(Rg + row * D + c0), q_rp = *(const u32x4*)(Rg + prow * D + c0);
        const u32x4 q_kc = *(const u32x4*)(Kg + row * D + c0), q_kp = *(const u32x4*)(Kg + prow * D + c0);
        const u32x4 q_vc = *(const u32x4*)(Vg + row * D + c0), q_vp = *(const u32x4*)(Vg + prow * D + c0);
        const u32x4 q_vf = *(const u32x4*)(VF + row * D + c0), q_zc = *(const u32x4*)(E5 + row * D + c0), q_hn = *(const u32x4*)(HN + row * D + c0);
        {
            const float* mx = mu + 3072;
            const u32x4 wc = n_wc, wp = n_wp, ac = n_ac, ap_ = n_ap, g0c = n_g0c, g0p = n_g0p, g1c = n_g1c, g1p = n_g1p; const u32x2 hvv = n_hv;
            float c[8], p[8], m[8], o[8];
            un8(wc, c); un8(wp, p); ld8f(mx + 8 * cg8, m);
#pragma unroll
            for (int i = 0; i < 8; ++i) { const float s = c[i] + (p[i] * pm - c[i]) * m[i]; o[i] = 2.0f * fsig(2.0f * s) - 1.0f; }
            *(LAS u32x4*)(AW + t * 72 + 8 * cg8) = pk8(o);
            un8(ac, c); un8(ap_, p); ld8f(mx + 64 + 8 * cg8, m);
#pragma unroll
            for (int i = 0; i < 8; ++i) o[i] = c[i] + (p[i] * pm - c[i]) * m[i];
            *(LAS u32x4*)(AA + t * 72 + 8 * cg8) = pk8(o);
            un8(g0c, c); un8(g0p, p); ld8f(mx + 128 + 16 * cg8, m);
#pragma unroll
            for (int i = 0; i < 8; ++i) o[i] = fsig(c[i] + (p[i] * pm - c[i]) * m[i]);
            *(LAS u32x4*)(AG + t * 136 + 16 * cg8) = pk8(o);
            un8(g1c, c); un8(g1p, p); ld8f(mx + 136 + 16 * cg8, m);
#pragma unroll
            for (int i = 0; i < 8; ++i) o[i] = fsig(c[i] + (p[i] * pm - c[i]) * m[i]);
            *(LAS u32x4*)(AG + t * 136 + 16 * cg8 + 8) = pk8(o);
            *(LAS u32x2*)(AV + t * 40 + 4 * cg8) = hvv;
        }
        BAR_LDS();
#pragma unroll
        for (int mi = 0; mi < 2; ++mi) {
            const int m = 2 * mh + mi;
            f32x4 cw = (f32x4){0.f, 0.f, 0.f, 0.f}, ca = cw, cgg = cw, cv = cw;
#pragma unroll
            for (int ks = 0; ks < 2; ++ks) { cw = mfma32(LDF8(AW + (16 * m + fr) * 72 + 32 * ks + 8 * fq), fw[ks], cw); ca = mfma32(LDF8(AA + (16 * m + fr) * 72 + 32 * ks + 8 * fq), fa[ks], ca); }
#pragma unroll
            for (int ks = 0; ks < 4; ++ks) cgg = mfma32(LDF8(AG + (16 * m + fr) * 136 + 32 * ks + 8 * fq), fg[ks], cgg);
            if (l > 0) cv = mfma32(LDF8(AV + (16 * m + fr) * 40 + 8 * fq), fv, cv);
#pragma unroll
            for (int rg = 0; rg < 4; ++rg) { const int o = (16 * m + 4 * fq + rg) * RST + 16 * nt + fr;
                LW[o] = -0.6065306597f * fsig(w0c + cw[rg]); PA[o] = fsig(a0c + ca[rg]); PG[o] = cgg[rg]; PV[o] = fsig(v0c + cv[rg]); }
        }
        BAR_LDS();
        {
            float pv[8]; float run = 0.f;
#pragma unroll
            for (int j = 0; j < 8; ++j) { run += LW[(8 * wave + j) * RST + lane]; pv[j] = run; }
            SEG[wave * 64 + lane] = run;
            BAR_LDS();
            float off = 0.f;
            for (int s = 0; s < wave; ++s) off += SEG[s * 64 + lane];
#pragma unroll
            for (int j = 0; j < 8; ++j) LW[(8 * wave + j) * RST + lane] = pv[j] + off;
        }
        BAR_LDS();
        {
            float r[8], k[8], v[8], p[8], m[8];
            un8(q_rc, r); un8(q_rp, p); ld8f(mu + c0, m);
#pragma unroll
            for (int i = 0; i < 8; ++i) r[i] += (p[i] * pm - r[i]) * m[i];
            un8(q_kc, k); un8(q_kp, p); ld8f(mu + 1024 + c0, m);
#pragma unroll
            for (int i = 0; i < 8; ++i) k[i] += (p[i] * pm - k[i]) * m[i];
            un8(q_vc, v); un8(q_vp, p); ld8f(mu + 2048 + c0, m);
#pragma unroll
            for (int i = 0; i < 8; ++i) v[i] += (p[i] * pm - v[i]) * m[i];
            if (l == 0) *(u32x4*)(VF + row * D + c0) = pk8(v);
            else { float vf[8]; un8(q_vf, vf);
#pragma unroll
                for (int i = 0; i < 8; ++i) v[i] += (vf[i] - v[i]) * PV[t * RST + 8 * cg8 + i]; }
            float kkc[8], kac[8], rkk[8], av[8], kn[8];
            ld8f(a.in[I_KK] + l * D + c0, kkc); ld8f(a.in[I_KA] + l * D + c0, kac); ld8f(a.in[I_RK] + l * D + c0, rkk);
            float ss = 0.f, bon = 0.f;
#pragma unroll
            for (int i = 0; i < 8; ++i) { av[i] = PA[t * RST + 8 * cg8 + i]; kn[i] = k[i] * kkc[i]; ss += kn[i] * kn[i]; k[i] = k[i] * (1.0f + (av[i] - 1.0f) * kac[i]); bon += r[i] * k[i] * rkk[i]; }
            ss = red8(ss); bon = red8(bon);
            const float inv = 1.0f / fmaxf(sqrtf(ss), 1e-12f);
            float oa[8], orr[8], ob[8], ok[8];
#pragma unroll
            for (int i = 0; i < 8; ++i) {
                const int lc = 8 * cg8 + i;
                const float Gt = LW[t * RST + lc], gpv_ = LW[((t > 0) ? t - 1 : 0) * RST + lc], Gp = (t > 0) ? gpv_ : 0.f, GC = LW[63 * RST + lc];
                const float knv = kn[i] * inv, bv = knv * av[i];
                const float eg = __expf(Gt), eng = __expf(-Gt), ecg = __expf(GC - Gt);
                oa[i] = -knv * __expf(Gp); orr[i] = r[i] * eg; ob[i] = bv * eng; ok[i] = k[i] * eng;
                BhT[lc * TS + t] = (bf16)f2bf(bv * ecg); KhT[lc * TS + t] = (bf16)f2bf(k[i] * ecg); Vt[lc * TS + t] = (bf16)f2bf(v[i]);
            }
            if (t == 63) {
#pragma unroll
                for (int i = 0; i < 8; ++i) gCg[uidx * 64 + 8 * cg8 + i] = expf(LW[63 * RST + 8 * cg8 + i]);
            }
            *(LAS u32x4*)(At + t * TS + 8 * cg8) = pk8(oa); *(LAS u32x4*)(Rt + t * TS + 8 * cg8) = pk8(orr);
            *(LAS u32x4*)(Bt + t * TS + 8 * cg8) = pk8(ob); *(LAS u32x4*)(Kt + t * TS + 8 * cg8) = pk8(ok);
            float lg[8], lb[8], zc[8], hn[8], g1[8], g2[8];
            ld8f(a.in[I_LNG] + l * D + c0, lg); ld8f(a.in[I_LNB] + l * D + c0, lb); un8(q_zc, zc); un8(q_hn, hn);
#pragma unroll
            for (int i = 0; i < 8; ++i) { const float gz = PG[t * RST + 8 * cg8 + i] * zc[i]; g1[i] = lg[i] * gz; g2[i] = hn[i] + (lb[i] + bon * v[i]) * gz; }
            *(u32x4*)(E5 + row * D + c0) = pk8(g1); *(u32x4*)(HN + row * D + c0) = pk8(g2);
        }
        BAR_LDS();
        {
            *(LAS u32x4*)(Xt + (16 * wave + (lane >> 2)) * TS + 16 * (lane & 3)) = (u32x4){0u, 0u, 0u, 0u};
            *(LAS u32x4*)(Xt + (16 * wave + (lane >> 2)) * TS + 16 * (lane & 3) + 8) = (u32x4){0u, 0u, 0u, 0u};
#pragma unroll
            for (int mi = 0; mi < 2; ++mi) {
                const int mt = 2 * mh + mi;
                f32x4 cab = (f32x4){0.f, 0.f, 0.f, 0.f}, cak = cab, crb = cab, crk = cab;
                if (nt <= mt) {
#pragma unroll
                    for (int ks = 0; ks < 2; ++ks) {
                        const bf16x8 fb = LDF8(Bt + (16 * nt + fr) * TS + 32 * ks + 8 * fq), fk = LDF8(Kt + (16 * nt + fr) * TS + 32 * ks + 8 * fq);
                        const bf16x8 fat = LDF8(At + (16 * mt + fr) * TS + 32 * ks + 8 * fq), frt = LDF8(Rt + (16 * mt + fr) * TS + 32 * ks + 8 * fq);
                        cab = mfma32(fb, fat, cab); cak = mfma32(fk, fat, cak); crb = mfma32(fb, frt, crb); crk = mfma32(fk, frt, crk);
                    }
                }
#pragma unroll
                for (int rg = 0; rg < 4; ++rg) { const int tl = fr, jl = 4 * fq + rg; const bool diag = (nt == mt);
                    const bool strict = !diag || (jl < tl), incl = !diag || (jl <= tl);
                    if (diag) cab[rg] = 0.f;
                    if (!strict) cak[rg] = 0.f;
                    if (!incl) { crb[rg] = 0.f; crk[rg] = 0.f; } }
                const int o = (16 * mt + fr) * TS + 16 * nt + 4 * fq;
                *(LAS bf16x4*)(Mab + o) = pk4(cab); *(LAS bf16x4*)(Mak + o) = pk4(cak); *(LAS bf16x4*)(Mrb + o) = pk4(crb); *(LAS bf16x4*)(Mrk + o) = pk4(crk);
            }
            if (wave < 4) { const int i = wave;
                f32x4 Pc = (f32x4){0.f, 0.f, 0.f, 0.f}, Pn = Pc;
#pragma unroll
                for (int ks = 0; ks < 2; ++ks) { const bf16x8 fat = LDF8(At + (16 * i + fr) * TS + 32 * ks + 8 * fq), fb = LDF8(Bt + (16 * i + fr) * TS + 32 * ks + 8 * fq);
                    Pc = mfma32(fat, fb, Pc); Pn = mfma32(fb, fat, Pn); }
                f32x4 Tc, Tn;
#pragma unroll
                for (int rg = 0; rg < 4; ++rg) { const int rr = 4 * fq + rg;
                    Pc[rg] = (fr < rr) ? Pc[rg] : 0.f;
                    Pn[rg] = (rr < fr) ? Pn[rg] : 0.f;
                    const float id = (rr == fr) ? 1.f : 0.f; Tc[rg] = id + Pc[rg]; Tn[rg] = id + Pn[rg]; }
#pragma unroll
                for (int st = 0; st < 3; ++st) {
                    const bf16x4 pcb = pk4(Pc), pnb = pk4(Pn);
                    const f32x4 z = (f32x4){0.f, 0.f, 0.f, 0.f};
                    const f32x4 P2 = mfma16(pnb, pcb, z), N2 = mfma16(pcb, pnb, z);
                    const bf16x4 tcb = pk4(Tc), tnb = pk4(Tn);
                    Tc = mfma16(tnb, pk4(P2), Tc); Tn = mfma16(tcb, pk4(N2), Tn);
                    Pc = P2; Pn = N2;
                }
                *(LAS bf16x4*)(TTl + (i * 64 + lane) * 4) = pk4(Tn);
            }
        }
        BAR_LDS();
        if (u + (int)gridDim.x < 8192) X1_PF(u + (int)gridDim.x, tl_);
        {
            bf16x4 tta[4];
#pragma unroll
            for (int i = 0; i < 4; ++i) tta[i] = *(const LAS bf16x4*)(TTl + (i * 64 + lane) * 4);
            LAS bf16* Xw = Xt + (16 * wave + fr) * TS;
#pragma unroll
            for (int i = 0; i < 4; ++i) {
                f32x4 acc = (f32x4){0.f, 0.f, 0.f, 0.f};
                if (wave < 4) {
#pragma unroll
                    for (int rg = 0; rg < 4; ++rg) acc[rg] = bf2f(At[(16 * i + 4 * fq + rg) * TS + 16 * wave + fr]);
                } else {
#pragma unroll
                    for (int ks = 0; ks < 2; ++ks) acc = mfma32(LDF8(Mak + (16 * i + fr) * TS + 32 * ks + 8 * fq), LDF8(Vt + (16 * (wave - 4) + fr) * TS + 32 * ks + 8 * fq), acc);
                }
                if (i > 0) {
#pragma unroll
                    for (int ks = 0; ks < 2; ++ks) acc = mfma32(LDF8(Mab + (16 * i + fr) * TS + 32 * ks + 8 * fq), LDF8(Xw + 32 * ks + 8 * fq), acc);
                }
                const f32x4 xi = mfma16(tta[i], pk4(acc), (f32x4){0.f, 0.f, 0.f, 0.f});
                *(LAS bf16x4*)(Xw + 16 * i + 4 * fq) = pk4(xi);
                LDS_WAIT();
            }
        }
        BAR_LDS();
        {
            bf16* Qu = Qg + uidx * 4096; bf16* Yu = Y0g + uidx * 4096; bf16* Pu = Ptg + uidx * 4096; bf16* Hu = Hg + uidx * 4096;
            const LAS bf16* Wt_ = Xt; const LAS bf16* U0t = Xt + 64 * TS;
#pragma unroll
            for (int mi = 0; mi < 2; ++mi) {
                const int mt = 2 * mh + mi;
                f32x4 cq = (f32x4){0.f, 0.f, 0.f, 0.f}, cy = cq, cp = cq, ch = cq;
#pragma unroll
                for (int ks = 0; ks < 2; ++ks) {
                    const int ko = 32 * ks + 8 * fq;
                    const bf16x8 wA = LDF8(Wt_ + (16 * mt + fr) * TS + ko), uA = LDF8(U0t + (16 * mt + fr) * TS + ko), vA = LDF8(Vt + (16 * mt + fr) * TS + ko);
                    const bf16x8 bhA = LDF8(BhT + (16 * mt + fr) * TS + ko), khA = LDF8(KhT + (16 * mt + fr) * TS + ko);
                    const bf16x8 rbB = LDF8(Mrb + (16 * nt + fr) * TS + ko), rkB = LDF8(Mrk + (16 * nt + fr) * TS + ko), bhB = LDF8(BhT + (16 * nt + fr) * TS + ko);
                    const bf16x8 uB = LDF8(U0t + (16 * nt + fr) * TS + ko), vB = LDF8(Vt + (16 * nt + fr) * TS + ko);
                    cq = mfma32(wA, rbB, cq);
                    cy = mfma32(uA, rbB, cy); cy = mfma32(vA, rkB, cy);
                    cp = mfma32(wA, bhB, cp);
                    ch = mfma32(bhA, uB, ch); ch = mfma32(khA, vB, ch);
                }
                { const u32x2 rw = *(const LAS u32x2*)(Rt + (16 * nt + fr) * TS + 16 * mt + 4 * fq); cq[0] += bflo(rw.x); cq[1] += bfhi(rw.x); cq[2] += bflo(rw.y); cq[3] += bfhi(rw.y); }
                const int o = (16 * nt + fr) * 64 + 16 * mt + 4 * fq;
                *(bf16x4*)(Qu + o) = pk4(cq); *(bf16x4*)(Yu + o) = pk4(cy); *(bf16x4*)(Pu + o) = pk4(cp); *(bf16x4*)(Hu + o) = pk4(ch);
            }
        }
        BAR_LDS();
    }
}
__device__ __forceinline__ void rwkv_x2_phase(const Args& a, LAS unsigned char* lds, int wave, int lane) {
    if (blockIdx.x >= 128) return;
    size_t wz_ = 0; asm volatile("" : "+s"(wz_)); unsigned char* ws = a.ws + wz_;
    const int bh = blockIdx.x >> 2, vb = blockIdx.x & 3, fr = lane & 15, fq = lane >> 4;
    const bf16* Ptg = (const bf16*)(ws + WS_E3); const bf16* Hg = (const bf16*)(ws + WS_E4); const float* gCg = (const float*)(ws + WS_AGA); bf16* Sg = (bf16*)(ws + WS_R);
    LAS bf16* St = (LAS bf16*)lds;
    if (wave < 4) {
        f32x4 S = (f32x4){0.f, 0.f, 0.f, 0.f};
        bf16x8 pa0[8], pa1[8]; u32x2 hh[8]; f32x4 gc[8];
        const bf16* pbase = Ptg + (size_t)bh * 4096 + (16 * wave + fr) * 64 + 8 * fq; const bf16* hbase = Hg + (size_t)bh * 4096 + (16 * vb + fr) * 64 + 16 * wave + 4 * fq; const float* gbase = gCg + (size_t)bh * 64 + 16 * wave + 4 * fq;
#define X2_LD(set_, chunk_) do { const size_t co_ = (size_t)(chunk_) * 32; pa0[set_] = *(const bf16x8*)(pbase + co_ * 4096); pa1[set_] = *(const bf16x8*)(pbase + co_ * 4096 + 32); \
            hh[set_] = *(const u32x2*)(hbase + co_ * 4096); gc[set_] = *(const f32x4*)(gbase + co_ * 64); } while (0)
#pragma unroll
        for (int j = 0; j < 8; ++j) X2_LD(j, j);
        for (int s0 = 0; s0 < 256; s0 += 8) {
#pragma unroll
            for (int j = 0; j < 8; ++j) {
                const int s = s0 + j;
                LAS bf16* Sc = St + (j & 1) * 16 * TS;
                *(LAS bf16x4*)(Sc + fr * TS + 16 * wave + 4 * fq) = pk4(S);
                BAR_LDS();
                const bf16x8 sb0 = LDF8(Sc + fr * TS + 8 * fq), sb1 = LDF8(Sc + fr * TS + 32 + 8 * fq);
                f32x4 nw = mfma32(pa0[j], sb0, (f32x4){0.f, 0.f, 0.f, 0.f}); nw = mfma32(pa1[j], sb1, nw);
                S[0] = S[0] * gc[j][0] + nw[0] + bflo(hh[j].x); S[1] = S[1] * gc[j][1] + nw[1] + bfhi(hh[j].x);
                S[2] = S[2] * gc[j][2] + nw[2] + bflo(hh[j].y); S[3] = S[3] * gc[j][3] + nw[3] + bfhi(hh[j].y);
                const int nx = (s + 8 < 256) ? s + 8 : 255;
                X2_LD(j, nx);
            }
        }
#undef X2_LD
    } else {
        const int myr = wave - 4;
        for (int s = 0; s < 256; ++s) {
            BAR_LDS();
            if ((s & 3) == myr) {
                const LAS bf16* sp_ = St + (s & 1) * 16 * TS + fr * TS + 4 * fq; bf16* Su_ = Sg + ((size_t)s * 32 + bh) * 4096 + (16 * vb + fr) * 64 + 4 * fq;
#pragma unroll
                for (int mt = 0; mt < 4; ++mt) *(u32x2*)(Su_ + 16 * mt) = *(const LAS u32x2*)(sp_ + 16 * mt);
            }
        }
    }
}
__device__ __forceinline__ void rwkv_x3_phase(const Args& a, LAS unsigned char* lds, int tid, int wave, int lane) {
    size_t wz_ = 0; asm volatile("" : "+s"(wz_)); unsigned char* ws = a.ws + wz_;
    const bf16* Qg = (const bf16*)(ws + WS_E1); const bf16* Y0g = (const bf16*)(ws + WS_E2); const bf16* Sg = (const bf16*)(ws + WS_R); const bf16* E5 = (const bf16*)(ws + WS_E5); bf16* HN = (bf16*)(ws + WS_HN);
    const int fr = lane & 15, fq = lane >> 4, nt = wave & 3, mh = wave >> 2, t = tid >> 3, cg8 = tid & 7;
    int par = 0;
    bf16x8 nS[2][2], nQ[2]; u32x2 nY[2]; u32x4 n_g1, n_hn;
#define X3_PF(u_) do { const int bh_ = (u_) & 31, ch_ = (u_) >> 5; const size_t ui_ = (size_t)ch_ * 32 + bh_; \
        const bf16* Su_ = Sg + ui_ * 4096; const bf16* Qu_ = Qg + ui_ * 4096; const bf16* Yu_ = Y0g + ui_ * 4096; \
        _Pragma("unroll") for (int mi = 0; mi < 2; ++mi) { _Pragma("unroll") for (int ks = 0; ks < 2; ++ks) nS[mi][ks] = *(const bf16x8*)(Su_ + (16 * (2 * mh + mi) + fr) * 64 + 32 * ks + 8 * fq); \
            nY[mi] = *(const u32x2*)(Yu_ + (16 * nt + fr) * 64 + 16 * (2 * mh + mi) + 4 * fq); } \
        _Pragma("unroll") for (int ks = 0; ks < 2; ++ks) nQ[ks] = *(const bf16x8*)(Qu_ + (16 * nt + fr) * 64 + 32 * ks + 8 * fq); \
        const size_t row_ = (size_t)(bh_ >> 4) * SEQ + (size_t)ch_ * 64 + t; const int c0_ = (bh_ & 15) * 64 + 8 * cg8; \
        n_g1 = *(const u32x4*)(E5 + row_ * D + c0_); n_hn = *(const u32x4*)(HN + row_ * D + c0_); } while (0)
    X3_PF((int)blockIdx.x);
    for (int u = blockIdx.x; u < 8192; u += gridDim.x, par ^= 1) {
        const int bh = u & 31, chunk = u >> 5, b = bh >> 4, hd = bh & 15;
        LAS float* YY = (LAS float*)(lds + par * RARR);
        const int c0 = hd * 64 + 8 * cg8; const size_t row = (size_t)b * SEQ + (size_t)chunk * 64 + t;
        bf16x8 cS[2][2], cQ[2]; u32x2 cY[2];
#pragma unroll
        for (int mi = 0; mi < 2; ++mi) { cS[mi][0] = nS[mi][0]; cS[mi][1] = nS[mi][1]; cY[mi] = nY[mi]; }
        cQ[0] = nQ[0]; cQ[1] = nQ[1];
        const u32x4 q_g1 = n_g1, q_hn = n_hn;
        if (u + (int)gridDim.x < 8192) X3_PF(u + (int)gridDim.x);
#pragma unroll
        for (int mi = 0; mi < 2; ++mi) {
            const int mt = 2 * mh + mi;
            f32x4 c = (f32x4){0.f, 0.f, 0.f, 0.f};
#pragma unroll
            for (int ks = 0; ks < 2; ++ks) c = mfma32(cS[mi][ks], cQ[ks], c);
            const u32x2 yw = cY[mi];
            c[0] += bflo(yw.x); c[1] += bfhi(yw.x); c[2] += bflo(yw.y); c[3] += bfhi(yw.y);
            *(LAS f32x4*)(YY + (16 * nt + fr) * RST + 16 * mt + 4 * fq) = c;
        }
        BAR_LDS();
        {
            float y[8], g1[8], hn[8], o[8]; float sm = 0.f;
#pragma unroll
            for (int i = 0; i < 8; ++i) { y[i] = YY[t * RST + 8 * cg8 + i]; sm += y[i]; }
            const float mean = red8(sm) * (1.0f / 64.0f); float q = 0.f;
#pragma unroll
            for (int i = 0; i < 8; ++i) { y[i] -= mean; q += y[i] * y[i]; }
            const float rs = rsqrtf(red8(q) * (1.0f / 64.0f) + 64.0f * 1e-5f);
            un8(q_g1, g1); un8(q_hn, hn);
#pragma unroll
            for (int i = 0; i < 8; ++i) o[i] = hn[i] + y[i] * rs * g1[i];
            *(u32x4*)(HN + row * D + c0) = pk8(o);
        }
    }
    BAR_LDS();
}


#define RLX_AGENT __ATOMIC_RELAXED, __HIP_MEMORY_SCOPE_AGENT
#define XB_TMO      128
#define XB_XCNT(j)  (256  + 64 * (j))
#define XB_XSUB(j)  (1280 + 64 * (j))
#define XB_XGEN(j)  (2304 + 64 * (j))
#define XB_TOP      3328
#define XB_TOPGEN   3392
#define XCD_BAR_WORDS 3456
#define XB_SPIN_CAP (1u << 18)

__device__ __forceinline__ unsigned xb_ld(unsigned* p)              { return __hip_atomic_load(p, __ATOMIC_RELAXED, __HIP_MEMORY_SCOPE_AGENT); }
__device__ __forceinline__ unsigned xb_add(unsigned* p, unsigned v) { return __hip_atomic_fetch_add(p, v, __ATOMIC_RELAXED, __HIP_MEMORY_SCOPE_AGENT); }
__device__ __forceinline__ unsigned xb_xcc_id() { return (unsigned)__builtin_amdgcn_s_getreg((3 << 11) | 20) & 0xFu; }
#define XB_SPIN(cond, bar) do { unsigned _sp = 0; while (cond) { __builtin_amdgcn_s_sleep(1); \
    if ((++_sp & 255u) == 0u) { if (xb_ld(&(bar)[XB_TMO])) break; if (_sp > XB_SPIN_CAP) { atomicAdd(&(bar)[XB_TMO], 1u); break; } } } } while (0)

struct XcdBarrier {
    unsigned* bar; unsigned x;
    volatile LAS unsigned* st;
};

__device__ __forceinline__ XcdBarrier xcd_barrier_post(unsigned* bar, volatile LAS unsigned* st) {
    XcdBarrier b; b.bar = bar; b.x = xb_xcc_id(); b.st = st;
    if (threadIdx.x == 0) (void)xb_add(&bar[XB_XCNT(b.x)], 1u);
    return b;
}
__device__ __forceinline__ void xcd_barrier_complete(unsigned* bar, unsigned x, unsigned& nloc, unsigned& nx) {
    const unsigned G = gridDim.x * gridDim.y * gridDim.z;
    unsigned sum, cnt, mine, sp = 0u;
    for (;;) {
        sum = 0u; cnt = 0u; mine = 0u;
#pragma unroll
        for (unsigned j = 0; j < 16; ++j) { const unsigned c = xb_ld(&bar[XB_XCNT(j)]); sum += c; cnt += (c > 0u) ? 1u : 0u; mine = (j == x) ? c : mine; }
        if (sum == G) break;
        __builtin_amdgcn_s_sleep(1);
        if ((++sp & 255u) == 0u) { if (xb_ld(&bar[XB_TMO])) break; if (sp > XB_SPIN_CAP) { atomicAdd(&bar[XB_TMO], 1u); break; } }
    }
    nloc = mine > 0u ? mine : 1u; nx = cnt > 0u ? cnt : 1u;
}

__device__ __forceinline__ void xcd_barrier(const XcdBarrier& b) {
    asm volatile("s_waitcnt vmcnt(0)" ::: "memory");
    __syncthreads();
    if (threadIdx.x == 0) {
        unsigned* bar = b.bar;
        __builtin_amdgcn_s_waitcnt(0);
        unsigned nloc = b.st[0], nx = b.st[1];
        if (nloc == 0u) { xcd_barrier_complete(bar, b.x, nloc, nx); b.st[0] = nloc; b.st[1] = nx; }
        const unsigned old = xb_add(&bar[XB_XSUB(b.x)], 1u);
        const unsigned gen = old / nloc;
        if (old + 1u == (gen + 1u) * nloc) {
            __builtin_amdgcn_fence(__ATOMIC_RELEASE, "agent");
            asm volatile("s_waitcnt vmcnt(0)" ::: "memory");
            const unsigned og = xb_add(&bar[XB_TOP], 1u);
            const unsigned tg = og / nx;
            if (og + 1u == (tg + 1u) * nx) xb_add(&bar[XB_TOPGEN], 1u);
            else XB_SPIN(xb_ld(&bar[XB_TOPGEN]) == tg, bar);
            __builtin_amdgcn_fence(__ATOMIC_ACQUIRE, "agent");
            xb_add(&bar[XB_XGEN(b.x)], 1u);
            asm volatile("s_waitcnt vmcnt(0)" ::: "memory");
        } else {
            XB_SPIN(xb_ld(&bar[XB_XGEN(b.x)]) == gen, bar);
            __builtin_amdgcn_fence(__ATOMIC_ACQUIRE, "agent");
            asm volatile("s_waitcnt vmcnt(0)" ::: "memory");
        }
    }
    __syncthreads();
}

__global__ void __launch_bounds__(NTHREADS, 2) fwd_megakernel(Args a) {
    extern __shared__ __attribute__((aligned(16))) unsigned char lds_raw[];
    cg::grid_group grid = cg::this_grid();
    LAS unsigned char* lds = (LAS unsigned char*)lds_raw;
    const int tid = threadIdx.x, lane0 = tid & 63, wave = __builtin_amdgcn_readfirstlane(tid >> 6);
    const int G = gridDim.x, gw = blockIdx.x * NWAVES + wave, NGW = G * NWAVES;
    unsigned char* ws = a.ws;
    bf16* HN = (bf16*)(ws + WS_HN);
    float* X = a.out;
    volatile LAS unsigned* MISC = (volatile LAS unsigned*)(lds + LDS_BYTES - 64);
    if (tid < 16) MISC[tid] = 0u;
    __syncthreads();
    const XcdBarrier xbar = xcd_barrier_post((unsigned*)ws, MISC);
    bool first_seam = true;
#define GRID_BAR() do { if (first_seam) { grid.sync(); first_seam = false; } else xcd_barrier(xbar); } while (0)
    for (int l = 0; l < DEPTH; ++l) {
        int lane = tid; asm volatile("" : "+v"(lane)); lane &= 63;
        const float* xin = (l == 0) ? a.in[I_X] : X;
        convert_weights(a, l, lds, gw, NGW, wave, lane, (l == 0 || G <= 128) ? 0 : 2);
        rms_rows_bf16(xin, a.in[I_N1G] + l * D, HN, gw, NGW, lane);
        GRID_BAR();
        { pg8::Gemm g{HN, (const bf16*)(ws + WS_WIN), T, NP, D}; pg8::StaticOrder S; S.init(T, NP, G, (int)blockIdx.x);
          pg8::EpiIn E{(bf16*)(ws + WS_E1), (bf16*)(ws + WS_XS), (bf16*)(ws + WS_HV), a.in[I_MB] + l * 3072};
          pg8::gemm_phase<pg8::EpiIn, pg8::StaticOrder, true, true>(lds, g, S, E); }
        GRID_BAR();
                {
            int tid_l = tid; asm volatile("" : "+v"(tid_l));
            lru_phase<false>(a, l, lds, gw, NGW, wave, lane);
            GRID_BAR();
            lru_carry_phase(a, lds, wave, lane);
            GRID_BAR();
            lru_phase<true>(a, l, lds, gw, NGW, wave, lane);
            GRID_BAR();
            rwkv_x1_phase(a, l, lds, tid_l, wave, lane);
            GRID_BAR();
            rwkv_x2_phase(a, lds, wave, lane);
            if ((int)blockIdx.x >= 128 && l + 1 < DEPTH) convert_weights(a, l + 1, lds, ((int)blockIdx.x - 128) * NWAVES + wave, (G - 128) * NWAVES, wave, lane, 1);
            GRID_BAR();
            rwkv_x3_phase(a, lds, tid_l, wave, lane);
            GRID_BAR();
        }

        { pg8::Gemm g{HN, (const bf16*)(ws + ((l & 1) ? WS_WOUT_B : WS_WOUT)), T, D, D}; pg8::StaticOrder S; S.init(T, D, G, (int)blockIdx.x);
          pg8::EpiRes E{xin, X};
          pg8::gemm_phase<pg8::EpiRes, pg8::StaticOrder, true, true>(lds, g, S, E); }
        GRID_BAR();
        rms_rows_bf16(X, a.in[I_N2G] + l * D, HN, gw, NGW, lane);
        GRID_BAR();
        { pg8::Gemm g{HN, (const bf16*)(ws + ((l & 1) ? WS_W1_B : WS_W1)), T, FF, D}; pg8::StaticOrder S; S.init(T, FF, G, (int)blockIdx.x);
          pg8::EpiRelu2 E{(bf16*)(ws + WS_HID)};
          pg8::gemm_phase<pg8::EpiRelu2, pg8::StaticOrder, true, true>(lds, g, S, E); }
        GRID_BAR();
        { pg8::Gemm g{(const bf16*)(ws + WS_HID), (const bf16*)(ws + WS_W2), T, D, FF}; pg8::StaticOrder S; S.init(T, D, G, (int)blockIdx.x);
          pg8::EpiRes E{X, X};
          pg8::gemm_phase<pg8::EpiRes, pg8::StaticOrder, true, true>(lds, g, S, E); }
        GRID_BAR();
    }
    { int lf = tid; asm volatile("" : "+v"(lf)); lf &= 63;
      rms_rows_f32(X, a.in[I_FG], gw, NGW, lf); }
}

extern "C" void kernel_launch(void* const* d_in, const int* in_sizes, int n_in, void* d_out, int out_size, void* d_ws, size_t ws_size, hipStream_t stream) {
    static int grid = 0;
    if (grid == 0) {
        if (n_in != 31 || out_size != T * D || ws_size < WS_END2) { fprintf(stderr, "kernel_launch: unexpected problem: n_in %d out %d ws %zu (need %zu)\n", n_in, out_size, ws_size, (size_t)WS_END2); grid = -1; return; }
        int dev = 0, cus = 0, per_cu = 0;
        hipGetDevice(&dev); hipDeviceGetAttribute(&cus, hipDeviceAttributeMultiprocessorCount, dev);
        if (hipFuncSetAttribute((const void*)fwd_megakernel, hipFuncAttributeMaxDynamicSharedMemorySize, LDS_BYTES) != hipSuccess) { fprintf(stderr, "kernel_launch: hipFuncSetAttribute failed\n"); grid = -1; return; }
        if (hipOccupancyMaxActiveBlocksPerMultiprocessor(&per_cu, (const void*)fwd_megakernel, NTHREADS, LDS_BYTES) != hipSuccess || per_cu < 1) { fprintf(stderr, "kernel_launch: occupancy query says %d\n", per_cu); per_cu = 1; }
        (void)hipGetLastError();
        grid = cus * per_cu;
        fprintf(stderr, "kernel_launch: grid %d (cus %d x %d) ws %zu\n", grid, cus, per_cu, ws_size);
    }
    if (grid < 0) return;
    if (hipMemsetAsync(d_ws, 0, 16384, stream) != hipSuccess) { fprintf(stderr, "kernel_launch: memset of the barrier words failed\n"); return; }
    Args a{};
    for (int i = 0; i < 31; ++i) a.in[i] = (const float*)d_in[i];
    a.out = (float*)d_out; a.ws = (unsigned char*)d_ws;
    void* args[] = {&a};
    hipError_t e = hipLaunchCooperativeKernel((const void*)fwd_megakernel, dim3(grid), dim3(NTHREADS), args, LDS_BYTES, stream);
    if (e != hipSuccess) fprintf(stderr, "cooperative launch failed: %s (grid %d)\n", hipGetErrorString(e), grid);
}
```

```cpp
#include <hip/hip_runtime.h>
#include <hip/hip_cooperative_groups.h>
#include <cstdio>
#include <cstdint>
namespace cg = cooperative_groups;
namespace pg8 {
#define PG8_LAS __attribute__((address_space(3)))
typedef unsigned short bf16_t;
typedef short bf16x8 __attribute__((ext_vector_type(8)));
typedef float f32x4 __attribute__((ext_vector_type(4)));
typedef unsigned u32x4 __attribute__((ext_vector_type(4)));
constexpr int BM = 256, BK = 64, HALF = 128, HTB = HALF * BK * 2  , STAGE_BYTES = 8 * HTB, NXCD = 8, WGM = 8;

__host__ __device__ __forceinline__ int lds_byte(int r, int c) { const int st = (r >> 4) * 2 + (c >> 5), rr = r & 15, cc = c & 31, ob = rr * 64 + cc * 2; return st * 1024 + (ob ^ (((ob >> 9) & 1) << 5)); }
__host__ __device__ __forceinline__ void stage_rc(int b, int& R, int& C) { const int st = b / 1024, sb = b % 1024, swz = sb ^ (((sb >> 9) & 1) << 5); R = (st >> 1) * 16 + swz / 64; C = (st & 1) * 32 + (swz % 64) / 2; }
__host__ __device__ __forceinline__ int perm32(int rho) { const int n = rho >> 4, i = rho & 15; return 8 * (i >> 2) + 4 * n + (i & 3); }

struct Unit { int pm, pn; };
struct Gemm { const bf16_t* A; const bf16_t* Bt; int M, N, K; };

struct StaticOrder {
    int nM, nN, nwg, G, c;
    __host__ __device__ void init(int M, int N, int G_, int c_) { nM = M / BM; nN = N / BM; nwg = nM * nN; G = G_; c = c_; }
    __host__ __device__ bool next(int i, Unit& u) const {
        const long L = (long)i * G + c; if (L >= nwg) return false;
        int wgid = (int)L; { const int q = nwg / NXCD, r = nwg % NXCD, xcd = wgid % NXCD, off = wgid / NXCD; wgid = (xcd < r ? xcd * (q + 1) : r * (q + 1) + (xcd - r) * q) + off; }
        const int nig = WGM * nN, gid = wgid / nig, fm = gid * WGM, gsz = (nM - fm) < WGM ? (nM - fm) : WGM;
        u.pm = fm + ((wgid % nig) % gsz); u.pn = (wgid % nig) / gsz; return true;
    }
    __device__ __forceinline__ void a_ready(const Unit&) const {}
    __device__ __forceinline__ void done(const Unit&) const {}
};
typedef __bf16 epi_bf16x2 __attribute__((ext_vector_type(2))); typedef float epi_f32x2 __attribute__((ext_vector_type(2)));
__device__ __forceinline__ unsigned cvt_pk_bf16(float lo, float hi) { const epi_f32x2 v = {lo, hi}; return __builtin_bit_cast(unsigned, __builtin_convertvector(v, epi_bf16x2)); }
__device__ __forceinline__ float fsigmoid(float x) { return __builtin_amdgcn_rcpf(1.0f + __expf(-x)); }
__device__ __forceinline__ float gelu_tanh(float x) { const float z = 1.5957691216f * (x + 0.044715f * x * x * x); return x * fsigmoid(z); }
__device__ __forceinline__ u32x4 pack8(const f32x4 a, const f32x4 b) { u32x4 w; w.x = cvt_pk_bf16(a[0], a[1]); w.y = cvt_pk_bf16(a[2], a[3]); w.z = cvt_pk_bf16(b[0], b[1]); w.w = cvt_pk_bf16(b[2], b[3]); return w; }

struct EpiIn {
    static constexpr bool PERM = true, AFTER_DRAIN = false;
    bf16_t *EB, *XS, *HV; const float* mb;
    __device__ __forceinline__ void operator()(const f32x4 (&acc)[2][2][4][2], const Unit& u, int wr, int wc, int fr, int fq) const {
        const int t = u.pn, row0 = u.pm * BM + wr * 64 + fr, cl = wc * 32 + 8 * fq;
        if (t < 24) {
            const int kind = t >> 3, ch = 128 * (t & 7) + cl;
            bf16_t* O = EB + (size_t)(kind == 2 ? 3 : kind) * ((size_t)32768 * 1024);
            f32x4 b0 = (f32x4){0.f, 0.f, 0.f, 0.f}, b1 = b0;
            if (kind != 1) { const float* mp = mb + (kind == 0 ? 0 : 1024) + ch; b0 = *(const f32x4*)mp; b1 = *(const f32x4*)(mp + 4); }
#pragma unroll
            for (int ai = 0; ai < 2; ++ai)
#pragma unroll
                for (int m = 0; m < 4; ++m) {
                    const f32x4 x0 = acc[ai][0][m][0], x1 = acc[ai][0][m][1], y0 = acc[ai][1][m][0] + b0, y1 = acc[ai][1][m][1] + b1;
                    f32x4 o0, o1;
#pragma unroll
                    for (int e = 0; e < 4; ++e) {
                        if (kind == 0) { o0[e] = x0[e] * fsigmoid(y0[e]); o1[e] = x1[e] * fsigmoid(y1[e]); }
                        else if (kind == 1) { o0[e] = x0[e] * y0[e]; o1[e] = x1[e] * y1[e]; }
                        else { o0[e] = gelu_tanh(x0[e]) * fsigmoid(y0[e]); o1[e] = gelu_tanh(x1[e]) * fsigmoid(y1[e]); }
                    }
                    *(u32x4*)(O + (size_t)(row0 + ai * HALF + m * 16) * 1024 + ch) = pack8(o0, o1);
                }
        } else if (t < 45) {
            bf16_t* O; int ld = 1024; const bool sg = (t >= 28 && t < 32); const int cb = (t < 44) ? 256 * (t & 3) : 0;
            if (t < 44) { const int idx = (t < 28) ? 2 : (t < 32 ? 4 : 5 + ((t - 32) >> 2)); O = EB + (size_t)idx * ((size_t)32768 * 1024); }
            else { O = XS; ld = 256; }
#pragma unroll
            for (int bj = 0; bj < 2; ++bj) {
                const int ch = cb + bj * HALF + cl;
                f32x4 b0 = (f32x4){0.f, 0.f, 0.f, 0.f}, b1 = b0;
                if (sg) { b0 = *(const f32x4*)(mb + 2048 + ch); b1 = *(const f32x4*)(mb + 2048 + ch + 4); }
#pragma unroll
                for (int ai = 0; ai < 2; ++ai)
#pragma unroll
                    for (int m = 0; m < 4; ++m) {
                        f32x4 o0 = acc[ai][bj][m][0], o1 = acc[ai][bj][m][1];
                        if (sg) {
#pragma unroll
                            for (int e = 0; e < 4; ++e) { o0[e] = fsigmoid(o0[e] + b0[e]); o1[e] = fsigmoid(o1[e] + b1[e]); }
                        }
                        *(u32x4*)(O + (size_t)(row0 + ai * HALF + m * 16) * ld + ch) = pack8(o0, o1);
                    }
            }
        } else {
            if (wc == 0) {
#pragma unroll
                for (int ai = 0; ai < 2; ++ai)
#pragma unroll
                    for (int m = 0; m < 4; ++m)
                        *(u32x4*)(HV + (size_t)(row0 + ai * HALF + m * 16) * 32 + cl) = pack8(acc[ai][0][m][0], acc[ai][0][m][1]);
            }
        }
    }
};
struct EpiRes {
    static constexpr bool PERM = false, AFTER_DRAIN = false;
    const float* base; float* out;
    __device__ __forceinline__ void operator()(const f32x4 (&acc)[2][2][4][2], const Unit& u, int wr, int wc, int fr, int fq) const {
        const int row0 = u.pm * BM + wr * 64 + fr, col0 = u.pn * BM + wc * 32 + 4 * fq;
#pragma unroll
        for (int ai = 0; ai < 2; ++ai) {
            f32x4 pre[4][2][2];
#pragma unroll
            for (int m = 0; m < 4; ++m) { const size_t off = (size_t)(row0 + ai * HALF + m * 16) * 1024 + col0;
#pragma unroll
                for (int bj = 0; bj < 2; ++bj)
#pragma unroll
                    for (int n = 0; n < 2; ++n) pre[m][bj][n] = *(const f32x4*)(base + off + bj * HALF + n * 16); }
            asm volatile("" ::: "memory");
#pragma unroll
            for (int m = 0; m < 4; ++m) { const size_t off = (size_t)(row0 + ai * HALF + m * 16) * 1024 + col0;
#pragma unroll
                for (int bj = 0; bj < 2; ++bj)
#pragma unroll
                    for (int n = 0; n < 2; ++n) *(f32x4*)(out + off + bj * HALF + n * 16) = pre[m][bj][n] + acc[ai][bj][m][n]; }
            asm volatile("" ::: "memory");
        }
    }
};
struct EpiRelu2 {
    static constexpr bool PERM = true, AFTER_DRAIN = false;
    bf16_t* O;
    __device__ __forceinline__ void operator()(const f32x4 (&acc)[2][2][4][2], const Unit& u, int wr, int wc, int fr, int fq) const {
        const int row0 = u.pm * BM + wr * 64 + fr, col0 = u.pn * BM + wc * 32 + 8 * fq;
#pragma unroll
        for (int ai = 0; ai < 2; ++ai)
#pragma unroll
            for (int m = 0; m < 4; ++m) { bf16_t* rowp = O + (size_t)(row0 + ai * HALF + m * 16) * 4096 + col0;
#pragma unroll
                for (int bj = 0; bj < 2; ++bj) { f32x4 v0 = acc[ai][bj][m][0], v1 = acc[ai][bj][m][1];
#pragma unroll
                    for (int e = 0; e < 4; ++e) { const float a = fmaxf(v0[e], 0.f), b = fmaxf(v1[e], 0.f); v0[e] = a * a; v1[e] = b * b; }
                    *(u32x4*)(rowp + bj * HALF) = pack8(v0, v1); } }
    }
};

template <class Epi, class Sched, bool ALIGN_EPI = false, bool SP2 = false>
__device__ __forceinline__ void gemm_phase(PG8_LAS unsigned char* lds, const Gemm g, const Sched& S, const Epi& E) {
    int tid_ = threadIdx.x; asm volatile("" : "+v"(tid_));
    const int tid = tid_, wid = __builtin_amdgcn_readfirstlane(tid >> 6), lane = tid & 63, wr = wid >> 2, wc = wid & 3, fr = lane & 15, fq = lane >> 4;
    const int K = g.K, nt = K / BK;
    unsigned voffA[2], voffB[2];
#pragma unroll
    for (int i = 0; i < 2; ++i) { int R, C; stage_rc(tid * 16 + i * 8192, R, C); const int Rb = Epi::PERM ? ((R & ~31) + perm32(R & 31)) : R;
        voffA[i] = (unsigned)(R * K + C) * 2u; voffB[i] = (unsigned)(Rb * K + C) * 2u; }
    const size_t kstep = (size_t)(BK * 2);
    const size_t hstep = (size_t)HALF * K * 2;
    const size_t tstep = 2 * hstep;
    const unsigned ldsw = (unsigned)wid * 1024u;
    const int aoff = lds_byte(wr * 64 + fr, fq * 8), boff = lds_byte(wc * 32 + fr, fq * 8);
#define PG8_SA(b, h) (((b) * 2 + (h)) * HTB)
#define PG8_SB(b, h) ((4 + (b) * 2 + (h)) * HTB)
#define PG8_STAGE(bufoff, gbase, voff) do { _Pragma("unroll") for (int _i = 0; _i < 2; ++_i) \
        __builtin_amdgcn_global_load_lds((const unsigned*)((const char*)(gbase) + (voff)[_i]), (PG8_LAS unsigned*)(lds + (bufoff) + ldsw + _i * 8192), 16, 0, 0); } while (0)
#define PG8_LDA(dst, b, h) do { _Pragma("unroll") for (int m = 0; m < 4; ++m) _Pragma("unroll") for (int k = 0; k < 2; ++k) dst[m][k] = *(const PG8_LAS bf16x8*)(lds + PG8_SA(b, h) + aoff + m * 2048 + k * 1024); } while (0)
#define PG8_LDB(dst, b, h) do { _Pragma("unroll") for (int n = 0; n < 2; ++n) _Pragma("unroll") for (int k = 0; k < 2; ++k) dst[n][k] = *(const PG8_LAS bf16x8*)(lds + PG8_SB(b, h) + boff + n * 2048 + k * 1024); } while (0)
#define PG8_MMA(ai, bj, At, Bt) do { __builtin_amdgcn_s_setprio(1); _Pragma("unroll") for (int m = 0; m < 4; ++m) _Pragma("unroll") for (int n = 0; n < 2; ++n) _Pragma("unroll") for (int k = 0; k < 2; ++k) \
        acc[ai][bj][m][n] = __builtin_amdgcn_mfma_f32_16x16x32_bf16(Bt[n][k], At[m][k], acc[ai][bj][m][n], 0, 0, 0); __builtin_amdgcn_s_setprio(0); } while (0)
#define PG8_WAIT_V(n) asm volatile("s_waitcnt vmcnt(" #n ")" ::: "memory")
#define PG8_WAIT_L(n) asm volatile("s_waitcnt lgkmcnt(" #n ")" ::: "memory")
#define PG8_BAR __builtin_amdgcn_s_barrier()
#define PG8_SCHED __builtin_amdgcn_sched_barrier(0)
    Unit cur, nxt; int ui = 0;
    if (!S.next(0, cur)) return;
    f32x4 acc[2][2][4][2];
#pragma unroll
    for (int a = 0; a < 2; ++a)
#pragma unroll
        for (int b = 0; b < 2; ++b)
#pragma unroll
            for (int m = 0; m < 4; ++m)
#pragma unroll
                for (int n = 0; n < 2; ++n) acc[a][b][m][n] = (f32x4){0.f, 0.f, 0.f, 0.f};
    bf16x8 At[4][2], B0[2][2], B1[2][2];
    const char* cA = (const char*)g.A + (size_t)cur.pm * tstep; const char* cB = (const char*)g.Bt + (size_t)cur.pn * tstep;
    S.a_ready(cur);
    if constexpr (SP2) {
        PG8_STAGE(PG8_SB(0, 0), cB, voffB); PG8_STAGE(PG8_SB(0, 1), cB + hstep, voffB); PG8_STAGE(PG8_SA(0, 0), cA, voffA); PG8_STAGE(PG8_SA(0, 1), cA + hstep, voffA);
        if (wr == 1) PG8_BAR;
        PG8_WAIT_V(2); PG8_BAR;
        PG8_STAGE(PG8_SB(1, 0), cB + kstep, voffB); PG8_STAGE(PG8_SA(1, 0), cA + kstep, voffA); PG8_STAGE(PG8_SB(1, 1), cB + hstep + kstep, voffB);
        PG8_WAIT_V(6); PG8_BAR;
    } else {
        PG8_STAGE(PG8_SB(0, 0), cB, voffB); PG8_STAGE(PG8_SA(0, 0), cA, voffA); PG8_STAGE(PG8_SB(0, 1), cB + hstep, voffB); PG8_STAGE(PG8_SA(0, 1), cA + hstep, voffA);
        if (wr == 1) PG8_BAR;
        PG8_WAIT_V(4); PG8_BAR;
        PG8_STAGE(PG8_SB(1, 0), cB + kstep, voffB); PG8_STAGE(PG8_SA(1, 0), cA + kstep, voffA); PG8_STAGE(PG8_SB(1, 1), cB + hstep + kstep, voffB);
        PG8_WAIT_V(6); PG8_BAR;
    }
    for (;;) {
        const bool has_next = S.next(ui + 1, nxt);
        const char* nA = has_next ? (const char*)g.A + (size_t)nxt.pm * tstep : cA; const char* nB = has_next ? (const char*)g.Bt + (size_t)nxt.pn * tstep : cB;
        for (int t = 0; t < nt; t += 2) {
            const bool last = (t == nt - 2);
            const char* a1 = cA + (size_t)(t + 1) * kstep;
            const char* a2 = last ? nA : cA + (size_t)(t + 2) * kstep; const char* b2 = last ? nB : cB + (size_t)(t + 2) * kstep;
            const char* a3 = a2 + kstep; const char* b3 = b2 + kstep;
            if (last && has_next) S.a_ready(nxt);
            if constexpr (SP2) {
            PG8_LDB(B0, 0, 0); PG8_LDB(B1, 0, 1); PG8_SCHED; PG8_LDA(At, 0, 0); PG8_STAGE(PG8_SA(1, 1), a1 + hstep, voffA);
            PG8_WAIT_V(8); PG8_WAIT_L(0); PG8_BAR; PG8_MMA(0, 0, At, B0); PG8_MMA(0, 1, At, B1); PG8_BAR; PG8_SCHED;
            PG8_LDA(At, 0, 1); PG8_STAGE(PG8_SB(0, 0), b2, voffB); PG8_STAGE(PG8_SB(0, 1), b2 + hstep, voffB); PG8_STAGE(PG8_SA(0, 0), a2, voffA);
            PG8_WAIT_V(8); PG8_WAIT_L(0); PG8_BAR; PG8_MMA(1, 0, At, B0); PG8_MMA(1, 1, At, B1); PG8_BAR; PG8_SCHED;
            PG8_LDB(B0, 1, 0); PG8_LDB(B1, 1, 1); PG8_SCHED; PG8_LDA(At, 1, 0); PG8_STAGE(PG8_SA(0, 1), a2 + hstep, voffA);
            PG8_WAIT_V(8); PG8_WAIT_L(0); PG8_BAR; PG8_MMA(0, 0, At, B0); PG8_MMA(0, 1, At, B1); PG8_BAR; PG8_SCHED;
            PG8_LDA(At, 1, 1); PG8_STAGE(PG8_SB(1, 0), b3, voffB); PG8_STAGE(PG8_SB(1, 1), b3 + hstep, voffB); PG8_STAGE(PG8_SA(1, 0), a3, voffA);
            PG8_WAIT_V(8); PG8_WAIT_L(0); PG8_BAR; PG8_MMA(1, 0, At, B0); PG8_MMA(1, 1, At, B1); PG8_BAR; PG8_SCHED;
            } else {
            PG8_LDB(B0, 0, 0); PG8_SCHED; PG8_LDA(At, 0, 0); PG8_STAGE(PG8_SA(1, 1), a1 + hstep, voffA);
            PG8_WAIT_L(8); PG8_BAR; PG8_WAIT_L(0); PG8_MMA(0, 0, At, B0); PG8_BAR; PG8_SCHED;
            PG8_LDB(B1, 0, 1); PG8_STAGE(PG8_SB(0, 0), b2, voffB);
            PG8_BAR; PG8_WAIT_L(0); PG8_MMA(0, 1, At, B1); PG8_BAR;
            PG8_LDA(At, 0, 1); PG8_STAGE(PG8_SA(0, 0), a2, voffA);
            PG8_BAR; PG8_WAIT_L(0); PG8_MMA(1, 0, At, B0); PG8_BAR; PG8_SCHED;
            PG8_STAGE(PG8_SB(0, 1), b2 + hstep, voffB);
            PG8_WAIT_V(6); PG8_BAR; PG8_MMA(1, 1, At, B1); PG8_BAR;
            PG8_LDB(B0, 1, 0); PG8_SCHED; PG8_LDA(At, 1, 0); PG8_STAGE(PG8_SA(0, 1), a2 + hstep, voffA);
            PG8_WAIT_L(8); PG8_BAR; PG8_WAIT_L(0); PG8_MMA(0, 0, At, B0); PG8_BAR; PG8_SCHED;
            PG8_LDB(B1, 1, 1); PG8_STAGE(PG8_SB(1, 0), b3, voffB);
            PG8_BAR; PG8_WAIT_L(0); PG8_MMA(0, 1, At, B1); PG8_BAR;
            PG8_LDA(At, 1, 1); PG8_STAGE(PG8_SA(1, 0), a3, voffA);
            PG8_BAR; PG8_WAIT_L(0); PG8_MMA(1, 0, At, B0); PG8_BAR; PG8_SCHED;
            PG8_STAGE(PG8_SB(1, 1), b3 + hstep, voffB);
            PG8_WAIT_V(6); PG8_BAR; PG8_MMA(1, 1, At, B1); PG8_BAR;
            }
        }
        if constexpr (ALIGN_EPI) { if (wr == 0) PG8_BAR; }
        if constexpr (!Epi::AFTER_DRAIN) { E(acc, cur, wr, wc, fr, fq); S.done(cur); __builtin_amdgcn_s_waitcnt(0x0F70);   }
        if (!has_next) break;
#pragma unroll
        for (int a = 0; a < 2; ++a)
#pragma unroll
            for (int b = 0; b < 2; ++b)
#pragma unroll
                for (int m = 0; m < 4; ++m)
#pragma unroll
                    for (int n = 0; n < 2; ++n) acc[a][b][m][n] = (f32x4){0.f, 0.f, 0.f, 0.f};
        cur = nxt; cA = nA; cB = nB; ++ui;
        if constexpr (ALIGN_EPI) { if (wr == 1) PG8_BAR; }
    }
    PG8_WAIT_V(0);
    if constexpr (!ALIGN_EPI) { if (wr == 0) PG8_BAR; }
    PG8_BAR;
    if constexpr (Epi::AFTER_DRAIN) { E.fused(acc, cur, wr, wc, fr, fq, lds, wid, lane); S.done(cur); }
#undef PG8_SA
#undef PG8_SB
#undef PG8_STAGE
#undef PG8_LDA
#undef PG8_LDB
#undef PG8_MMA
#undef PG8_WAIT_V
#undef PG8_WAIT_L
#undef PG8_BAR
#undef PG8_SCHED
}
}
#define LAS __attribute__((address_space(3)))
typedef unsigned short bf16;
typedef float f32x4 __attribute__((ext_vector_type(4)));
typedef float f32x2 __attribute__((ext_vector_type(2)));
typedef unsigned u32x4 __attribute__((ext_vector_type(4)));
typedef unsigned u32x2 __attribute__((ext_vector_type(2)));
typedef short bf16x8 __attribute__((ext_vector_type(8)));
constexpr int T = 32768, SEQ = 16384, D = 1024, NIN = 11520, NP = 11776, FF = 4096, DEPTH = 4;
constexpr int NWAVES = 8, NTHREADS = 512;
constexpr int LDS_BYTES = 163840;
constexpr float EPS = 1e-6f;
constexpr size_t MiB = 1u << 20;
constexpr size_t WS_WIN = 1 * MiB, WS_WOUT = 24 * MiB, WS_W1 = 26 * MiB, WS_W2 = 34 * MiB, WS_HN = 42 * MiB, WS_VF = 106 * MiB;
constexpr size_t WS_E1 = 170 * MiB, WS_E2 = 234 * MiB, WS_E3 = 298 * MiB, WS_E4 = 362 * MiB, WS_E5 = 426 * MiB, WS_R = 490 * MiB, WS_K = 554 * MiB, WS_V = 618 * MiB;
constexpr size_t WS_XS = 682 * MiB, WS_HV = 698 * MiB, WS_AGA = 700 * MiB, WS_AGH = 702 * MiB, WS_CAR = 704 * MiB, WS_END = 706 * MiB;
constexpr size_t WS_HID = WS_E1;

struct Args { const float* in[31]; float* out; unsigned char* ws; };
enum { I_X = 0, I_N1G, I_WIN, I_MB, I_CAW, I_LCW, I_LCB, I_LWA, I_LBA, I_LWI, I_LBI, I_LAP, I_MU, I_W0, I_W2, I_A0, I_A2, I_G2, I_KK, I_KA, I_RK, I_LNG, I_LNB, I_V0, I_V1, I_V2, I_WOUT, I_N2G, I_MW1, I_MW2, I_FG };

typedef __bf16 hwbf16x2 __attribute__((ext_vector_type(2)));
__device__ __forceinline__ unsigned pk2(float lo, float hi) { const f32x2 v = {lo, hi}; return __builtin_bit_cast(unsigned, __builtin_convertvector(v, hwbf16x2)); }
__device__ __forceinline__ unsigned f2bf(float f) { return pk2(f, 0.f) & 0xffffu; }
__device__ __forceinline__ float bf2f(unsigned short b) { return __builtin_bit_cast(float, (unsigned)b << 16); }
__device__ __forceinline__ float bflo(unsigned w) { return __builtin_bit_cast(float, w << 16); }
__device__ __forceinline__ float bfhi(unsigned w) { return __builtin_bit_cast(float, w & 0xffff0000u); }
#define LDS_WAIT() asm volatile("s_waitcnt lgkmcnt(0)" ::: "memory")
__device__ __forceinline__ float wave_sum(float v) {
#pragma unroll
    for (int o = 1; o < 64; o <<= 1) v += __shfl_xor(v, o);
    return v;
}

__device__ __forceinline__ void transpose_item(const float* W, int K, int N, int k0, int nsrc, bool zero, bf16* WT, int drow, LAS float* scr, int lane) {
    float wv_[32];
#pragma unroll
    for (int i = 0; i < 32; ++i) { const int kk = 2 * i + (lane >> 5); wv_[i] = zero ? 0.f : W[(size_t)(k0 + kk) * N + nsrc + (lane & 31)]; }
#pragma unroll
    for (int i = 0; i < 32; ++i) { const int kk = 2 * i + (lane >> 5); scr[kk * 33 + (lane & 31)] = wv_[i]; }
    LDS_WAIT();
    const int c = lane & 7;
#pragma unroll
    for (int j = 0; j < 4; ++j) { const int n = (lane >> 3) + 8 * j; const LAS float* s = scr + (8 * c) * 33 + n;
        u32x4 o; o.x = pk2(s[0 * 33], s[1 * 33]); o.y = pk2(s[2 * 33], s[3 * 33]); o.z = pk2(s[4 * 33], s[5 * 33]); o.w = pk2(s[6 * 33], s[7 * 33]);
        *(u32x4*)(WT + (size_t)(drow + n) * K + k0 + 8 * c) = o; }
    LDS_WAIT();
}
__device__ __forceinline__ int win_src_col(int nb) {
    const int t = nb >> 3, q = nb & 7, bj = q >> 2, o = (q & 3) * 32;
    if (t < 8) return (bj == 0 ? 0 : 5120) + 128 * t + o;
    if (t < 16) return (bj == 0 ? 1024 : 2048) + 128 * (t - 8) + o;
    if (t < 24) return (bj == 0 ? 4096 : 6144) + 128 * (t - 16) + o;
    if (t < 28) return 3072 + 256 * (t - 24) + 128 * bj + o;
    if (t < 32) return 7168 + 256 * (t - 28) + 128 * bj + o;
    return 8192 + 256 * (t - 32) + 128 * bj + o;
}
__device__ __forceinline__ void convert_weights(const Args& a, int l, LAS unsigned char* lds, int gw, int NGW, int wave, int lane, int part  ) {
    LAS float* scr = (LAS float*)(lds + wave * 16384);
    size_t wz_ = 0; asm volatile("" : "+s"(wz_)); unsigned char* ws = a.ws + wz_;
    constexpr int I_IN = 16 * (NP / 32), I_O = 16 * 32, I_1 = 16 * (FF / 32), I_2 = 64 * 32;
    const int it_lo = (part == 2) ? I_IN : 0, it_hi = (part == 1) ? I_IN : I_IN + I_O + I_1 + I_2;
    for (int it = it_lo + gw; it < it_hi; it += NGW) {
        int r = it;
        if (r < I_IN) { const int kb = r / (NP / 32), nb = r % (NP / 32);
            if (nb < 360) transpose_item(a.in[I_WIN] + (size_t)l * D * NIN, D, NIN, 64 * kb, win_src_col(nb), false, (bf16*)(ws + WS_WIN), 32 * nb, scr, lane);
            else { const bool real = (nb == 360) && (l > 0); transpose_item(a.in[I_V1] + (size_t)(real ? l - 1 : 0) * D * 32, D, 32, 64 * kb, 0, !real, (bf16*)(ws + WS_WIN), 32 * nb, scr, lane); }
            continue; }
        r -= I_IN;
        if (r < I_O) { transpose_item(a.in[I_WOUT] + (size_t)l * D * D, D, D, 64 * (r / 32), 32 * (r % 32), false, (bf16*)(ws + WS_WOUT), 32 * (r % 32), scr, lane); continue; }
        r -= I_O;
        if (r < I_1) { transpose_item(a.in[I_MW1] + (size_t)l * D * FF, D, FF, 64 * (r / 128), 32 * (r % 128), false, (bf16*)(ws + WS_W1), 32 * (r % 128), scr, lane); continue; }
        r -= I_1;
        transpose_item(a.in[I_MW2] + (size_t)l * FF * D, FF, D, 64 * (r / 32), 32 * (r % 32), false, (bf16*)(ws + WS_W2), 32 * (r % 32), scr, lane);
    }
}
__device__ __forceinline__ void rms_row_bf16(const float* xrow, const float* g, bf16* orow, int lane) {
    const f32x4* xr = (const f32x4*)xrow + lane; f32x4 v[4]; float s = 0.f;
#pragma unroll
    for (int j = 0; j < 4; ++j) { v[j] = xr[64 * j]; s += (v[j].x * v[j].x + v[j].y * v[j].y) + (v[j].z * v[j].z + v[j].w * v[j].w); }
    const float rstd = rsqrtf(wave_sum(s) * (1.f / D) + EPS);
    u32x2* o8 = (u32x2*)orow + lane;
#pragma unroll
    for (int j = 0; j < 4; ++j) { const f32x4 gv = ((const f32x4*)g)[lane + 64 * j]; u32x2 w; w.x = pk2(v[j].x * rstd * gv.x, v[j].y * rstd * gv.y); w.y = pk2(v[j].z * rstd * gv.z, v[j].w * rstd * gv.w); o8[64 * j] = w; }
}
__device__ __forceinline__ void rms_rows_bf16(const float* x, const float* g, bf16* out, int gw, int NGW, int lane) {
    f32x4 gv[4], nv[4];
#pragma unroll
    for (int j = 0; j < 4; ++j) gv[j] = ((const f32x4*)g)[lane + 64 * j];
    if (gw < T) {
#pragma unroll
        for (int j = 0; j < 4; ++j) nv[j] = ((const f32x4*)(x + (size_t)gw * D))[lane + 64 * j];
    }
    for (int m = gw; m < T; m += NGW) {
        f32x4 v[4]; float s = 0.f;
#pragma unroll
        for (int j = 0; j < 4; ++j) { v[j] = nv[j]; s += (v[j].x * v[j].x + v[j].y * v[j].y) + (v[j].z * v[j].z + v[j].w * v[j].w); }
        const int mn = (m + NGW < T) ? m + NGW : m;
#pragma unroll
        for (int j = 0; j < 4; ++j) nv[j] = ((const f32x4*)(x + (size_t)mn * D))[lane + 64 * j];
        const float rstd = rsqrtf(wave_sum(s) * (1.f / D) + EPS);
        u32x2* o8 = (u32x2*)(out + (size_t)m * D) + lane;
#pragma unroll
        for (int j = 0; j < 4; ++j) { u32x2 w; w.x = pk2(v[j].x * rstd * gv[j].x, v[j].y * rstd * gv[j].y); w.y = pk2(v[j].z * rstd * gv[j].z, v[j].w * rstd * gv[j].w); o8[64 * j] = w; }
    }
}
__device__ __forceinline__ void rms_rows_f32(float* x, const float* g, int gw, int NGW, int lane) {
    f32x4 gv[4], nv[4];
#pragma unroll
    for (int j = 0; j < 4; ++j) gv[j] = ((const f32x4*)g)[lane + 64 * j];
    if (gw < T) {
#pragma unroll
        for (int j = 0; j < 4; ++j) nv[j] = ((const f32x4*)(x + (size_t)gw * D))[lane + 64 * j];
    }
    for (int m = gw; m < T; m += NGW) {
        f32x4 v[4]; float s = 0.f;
#pragma unroll
        for (int j = 0; j < 4; ++j) { v[j] = nv[j]; s += (v[j].x * v[j].x + v[j].y * v[j].y) + (v[j].z * v[j].z + v[j].w * v[j].w); }
        if (m + NGW < T) {
#pragma unroll
            for (int j = 0; j < 4; ++j) nv[j] = ((const f32x4*)(x + (size_t)(m + NGW) * D))[lane + 64 * j];
        }
        const float rstd = rsqrtf(wave_sum(s) * (1.f / D) + EPS);
        f32x4* xr = (f32x4*)(x + (size_t)m * D) + lane;
#pragma unroll
        for (int j = 0; j < 4; ++j) xr[64 * j] = v[j] * rstd * gv[j];
    }
}
__device__ __forceinline__ void rms_row_f32(float* xrow, const float* g, int lane) {
    f32x4* xr = (f32x4*)xrow + lane; f32x4 v[4]; float s = 0.f;
#pragma unroll
    for (int j = 0; j < 4; ++j) { v[j] = xr[64 * j]; s += (v[j].x * v[j].x + v[j].y * v[j].y) + (v[j].z * v[j].z + v[j].w * v[j].w); }
    const float rstd = rsqrtf(wave_sum(s) * (1.f / D) + EPS);
#pragma unroll
    for (int j = 0; j < 4; ++j) { const f32x4 gv = ((const f32x4*)g)[lane + 64 * j]; xr[64 * j] = v[j] * rstd * gv; }
}

__device__ __forceinline__ float fsig(float x) { return __builtin_amdgcn_rcpf(1.0f + __expf(-x)); }
__device__ __forceinline__ void ld8bf(const bf16* p, float (&o)[8]) { const u32x4 w = *(const u32x4*)p; o[0] = bflo(w.x); o[1] = bfhi(w.x); o[2] = bflo(w.y); o[3] = bfhi(w.y); o[4] = bflo(w.z); o[5] = bfhi(w.z); o[6] = bflo(w.w); o[7] = bfhi(w.w); }
__device__ __forceinline__ void un8(const u32x4 w, float (&o)[8]) { o[0] = bflo(w.x); o[1] = bfhi(w.x); o[2] = bflo(w.y); o[3] = bfhi(w.y); o[4] = bflo(w.z); o[5] = bfhi(w.z); o[6] = bflo(w.w); o[7] = bfhi(w.w); }
__device__ __forceinline__ void ld8f(const float* p, float (&o)[8]) { const f32x4 a = *(const f32x4*)p, b = *(const f32x4*)(p + 4); o[0] = a.x; o[1] = a.y; o[2] = a.z; o[3] = a.w; o[4] = b.x; o[5] = b.y; o[6] = b.z; o[7] = b.w; }
__device__ __forceinline__ u32x4 pk8(const float (&v)[8]) { u32x4 w; w.x = pk2(v[0], v[1]); w.y = pk2(v[2], v[3]); w.z = pk2(v[4], v[5]); w.w = pk2(v[6], v[7]); return w; }
__device__ __forceinline__ bf16x8 frag_from_f32(const float* p, int stride) {
    u32x4 w; w.x = pk2(p[0], p[stride]); w.y = pk2(p[2 * stride], p[3 * stride]); w.z = pk2(p[4 * stride], p[5 * stride]); w.w = pk2(p[6 * stride], p[7 * stride]);
    return __builtin_bit_cast(bf16x8, w);
}
template <int CTRL> __device__ __forceinline__ float dpp_f(float x) { return __builtin_bit_cast(float, __builtin_amdgcn_update_dpp(0, __builtin_bit_cast(int, x), CTRL, 0xf, 0xf, true)); }
__device__ __forceinline__ float red8(float x) {
    x += dpp_f<0xB1>(x);
    x += dpp_f<0x4E>(x);
    x += dpp_f<0x141>(x);
    return x;
}

template <bool PASS3>
__device__ __forceinline__ void lru_phase(const Args& a, int l, LAS unsigned char* lds, int gw, int NGW, int wave, int lane) {
    LAS unsigned char* wl = lds + wave * 16384;
    LAS bf16* Ubf = (LAS bf16*)wl; LAS float* Uf = (LAS float*)(wl + 2304); LAS float* Ab = (LAS float*)(wl + 6528); LAS float* Hb = (LAS float*)(wl + 10752);
    size_t wz_ = 0; asm volatile("" : "+s"(wz_)); unsigned char* ws = a.ws + wz_;
    const bf16* XB = (const bf16*)(ws + WS_E3);
    float* AGA = (float*)(ws + WS_AGA); float* AGH = (float*)(ws + WS_AGH); const float* CAR = (const float*)(ws + WS_CAR);
    const float* cw = a.in[I_LCW] + (size_t)l * 4 * D; const float* cbp = a.in[I_LCB] + (size_t)l * D;
    const int fr = lane & 15, fq = lane >> 4;
    int cur_hh = -1;
    bf16x8 wfa[2][4], wfi[2][4];
    float ba_[4], bi_[4], sp_[4];
    float cw0 = 0.f, cw1 = 0.f, cw2 = 0.f, cw3 = 0.f, cbv = 0.f;
    for (int u = gw; u < 8192; u += NGW) {
        const int hh = u & 15, cidx = u >> 4, chunk = cidx & 255, b = cidx >> 8;
        const int ch0 = hh * 64; const size_t row0 = (size_t)b * SEQ + (size_t)chunk * 64;
        if (hh != cur_hh) {
            cur_hh = hh;
            const float* wa = a.in[I_LWA] + ((size_t)l * 16 + hh) * 4096; const float* wi = a.in[I_LWI] + ((size_t)l * 16 + hh) * 4096;
#pragma unroll
            for (int ks = 0; ks < 2; ++ks)
#pragma unroll
                for (int nt = 0; nt < 4; ++nt) { const int off = (32 * ks + 8 * fq) * 64 + 16 * nt + fr; wfa[ks][nt] = frag_from_f32(wa + off, 64); wfi[ks][nt] = frag_from_f32(wi + off, 64); }
#pragma unroll
            for (int nt = 0; nt < 4; ++nt) { const int c = l * D + ch0 + 16 * nt + fr; ba_[nt] = a.in[I_LBA][c]; bi_[nt] = a.in[I_LBI][c]; sp_[nt] = log1pf(expf(a.in[I_LAP][c])); }
            const int c = ch0 + lane; cw0 = cw[c]; cw1 = cw[D + c]; cw2 = cw[2 * D + c]; cw3 = cw[3 * D + c]; cbv = cbp[c];
        }
        const float hm = (chunk > 0) ? 1.0f : 0.0f; const size_t hrow = (chunk > 0) ? row0 - 3 : row0;
        float xm3, xm2, xm1;
        { const bf16* p = XB + hrow * D + ch0 + lane; const unsigned short h0 = p[0], h1 = p[D], h2 = p[2 * D]; xm3 = bf2f(h0) * hm; xm2 = bf2f(h1) * hm; xm1 = bf2f(h2) * hm; }
        float hc = 0.f, ap = 1.f;
        if (PASS3) hc = CAR[(size_t)cidx * D + ch0 + lane];
        unsigned short xn[16];
#pragma unroll
        for (int t = 0; t < 16; ++t) xn[t] = XB[(row0 + t) * D + ch0 + lane];
        for (int mt = 0; mt < 4; ++mt) {
            const size_t r0 = row0 + mt * 16;
            float xv[16];
#pragma unroll
            for (int t = 0; t < 16; ++t) xv[t] = bf2f(xn[t]);
            { const size_t rn = row0 + ((mt < 3) ? mt + 1 : 3) * 16;
#pragma unroll
              for (int t = 0; t < 16; ++t) xn[t] = XB[(rn + t) * D + ch0 + lane]; }
            const int ct = lane >> 2, cq = lane & 3, cc = ch0 + cq * 16; const size_t cr = r0 + ct; const int tseq = chunk * 64 + mt * 16 + ct;
            u32x4 qza[2], qzb[2], qx2[2], qx1[2], qx0[2];
            if (PASS3) {
                const bf16* E1p = (const bf16*)(ws + WS_E1) + cr * D + cc; const bf16* E2p = (const bf16*)(ws + WS_E2) + cr * D + cc; const bf16* E4p = (const bf16*)(ws + WS_E4) + cr * D + cc;
                const bf16* E2p1 = E2p - ((tseq >= 1) ? D : 0); const bf16* E2p0 = E2p - ((tseq >= 2) ? 2 * D : 0);
#pragma unroll
                for (int h8 = 0; h8 < 2; ++h8) { qza[h8] = *(const u32x4*)(E1p + 8 * h8); qzb[h8] = *(const u32x4*)(E4p + 8 * h8); qx2[h8] = *(const u32x4*)(E2p + 8 * h8); qx1[h8] = *(const u32x4*)(E2p1 + 8 * h8); qx0[h8] = *(const u32x4*)(E2p0 + 8 * h8); }
            }
#pragma unroll
            for (int t = 0; t < 16; ++t) { const float uu = cbv + cw0 * xm3 + cw1 * xm2 + cw2 * xm1 + cw3 * xv[t]; xm3 = xm2; xm2 = xm1; xm1 = xv[t]; Ubf[t * 72 + lane] = (bf16)f2bf(uu); Uf[t * 66 + lane] = uu; }
            LDS_WAIT();
            bf16x8 af[2];
#pragma unroll
            for (int ks = 0; ks < 2; ++ks) af[ks] = *(const LAS bf16x8*)(Ubf + fr * 72 + 32 * ks + 8 * fq);
            f32x4 ca[4], ci[4];
#pragma unroll
            for (int nt = 0; nt < 4; ++nt) { ca[nt] = (f32x4){0.f, 0.f, 0.f, 0.f}; ci[nt] = ca[nt];
#pragma unroll
                for (int ks = 0; ks < 2; ++ks) { ca[nt] = __builtin_amdgcn_mfma_f32_16x16x32_bf16(af[ks], wfa[ks][nt], ca[nt], 0, 0, 0); ci[nt] = __builtin_amdgcn_mfma_f32_16x16x32_bf16(af[ks], wfi[ks][nt], ci[nt], 0, 0, 0); } }
#pragma unroll
            for (int nt = 0; nt < 4; ++nt)
#pragma unroll
                for (int rg = 0; rg < 4; ++rg) { const int tok = 4 * fq + rg, c = 16 * nt + fr;
                    const float ga = fsig(ca[nt][rg] + ba_[nt]), gi = fsig(ci[nt][rg] + bi_[nt]);
                    const float la = -8.0f * ga * sp_[nt]; const float av = __expf(la); float mult = __builtin_amdgcn_sqrtf(fmaxf(1.0f - av * av, 0.f));
                    if (chunk == 0 && mt == 0 && tok == 0) mult = 1.0f;
                    Ab[tok * 66 + c] = av; Hb[tok * 66 + c] = Uf[tok * 66 + c] * gi * mult; }
            LDS_WAIT();
#pragma unroll
            for (int t = 0; t < 16; ++t) { const float av = Ab[t * 66 + lane], uu = Hb[t * 66 + lane]; hc = av * hc + uu; ap *= av; if (PASS3) Hb[t * 66 + lane] = hc; }
            if (PASS3) {
                LDS_WAIT();
                bf16* Mp = (bf16*)(ws + WS_HN) + cr * D + cc; const float* caw = a.in[I_CAW] + (size_t)l * 3 * D + cc;
                const float m1 = (tseq >= 1) ? 1.0f : 0.0f, m0 = (tseq >= 2) ? 1.0f : 0.0f;
#pragma unroll
                for (int h8 = 0; h8 < 2; ++h8) {
                    float za[8], zb[8], x0[8], x1[8], x2[8], w0[8], w1[8], w2[8], o[8];
                    un8(qza[h8], za); un8(qzb[h8], zb); un8(qx2[h8], x2); un8(qx1[h8], x1); un8(qx0[h8], x0);
                    ld8f(caw + 8 * h8, w0); ld8f(caw + D + 8 * h8, w1); ld8f(caw + 2 * D + 8 * h8, w2);
#pragma unroll
                    for (int i = 0; i < 8; ++i) { const float hv = Hb[ct * 66 + cq * 16 + 8 * h8 + i]; o[i] = za[i] * (w0[i] * m0 * x0[i] + w1[i] * m1 * x1[i] + w2[i] * x2[i]) + zb[i] * hv; }
                    *(u32x4*)(Mp + 8 * h8) = pk8(o);
                }
            }
            LDS_WAIT();
        }
        if (!PASS3) { AGA[(size_t)cidx * D + ch0 + lane] = ap; AGH[(size_t)cidx * D + ch0 + lane] = hc; }
    }
}
__device__ __forceinline__ void lru_carry_phase(const Args& a, LAS unsigned char* lds, int wave, int lane) {
    if (blockIdx.x >= 32) return;
    const int b = blockIdx.x >> 4, c = (blockIdx.x & 15) * 64 + lane;
    size_t wz_ = 0; asm volatile("" : "+s"(wz_)); unsigned char* ws = a.ws + wz_;
    const float* AGA = (const float*)(ws + WS_AGA) + ((size_t)b * 256 + 32 * wave) * D + c; const float* AGH = (const float*)(ws + WS_AGH) + ((size_t)b * 256 + 32 * wave) * D + c;
    float* CAR = (float*)(ws + WS_CAR) + ((size_t)b * 256 + 32 * wave) * D + c;
    LAS float* SA = (LAS float*)lds; LAS float* SH = SA + 512;
    float av[32], hv[32];
#pragma unroll
    for (int i = 0; i < 32; ++i) { av[i] = AGA[(size_t)i * D]; hv[i] = AGH[(size_t)i * D]; }
    float pa = 1.f, ph = 0.f;
#pragma unroll
    for (int i = 0; i < 32; ++i) { const float a_ = av[i], h_ = hv[i]; av[i] = pa; hv[i] = ph; ph = a_ * ph + h_; pa *= a_; }
    SA[wave * 64 + lane] = pa; SH[wave * 64 + lane] = ph;
    __syncthreads();
    float cin = 0.f;
    for (int s = 0; s < wave; ++s) cin = SA[s * 64 + lane] * cin + SH[s * 64 + lane];
#pragma unroll
    for (int i = 0; i < 32; ++i) CAR[(size_t)i * D] = av[i] * cin + hv[i];
}

constexpr int RST = 68, RARR = 64 * RST * 4;
__device__ __forceinline__ void rwkv_naive_phase(const Args& a, int l, LAS unsigned char* lds, int tid, int wave, int lane) {
    if (blockIdx.x >= 32) return;
    const int b = blockIdx.x >> 4, hd = blockIdx.x & 15;
    size_t wz_ = 0; asm volatile("" : "+s"(wz_)); unsigned char* ws = a.ws + wz_;
    LAS float* PW = (LAS float*)(lds + 0 * RARR); LAS float* PA = (LAS float*)(lds + 1 * RARR); LAS float* PV = (LAS float*)(lds + 2 * RARR); LAS float* PG = (LAS float*)(lds + 3 * RARR);
    LAS float* RR = (LAS float*)(lds + 4 * RARR); LAS float* KK = (LAS float*)(lds + 5 * RARR); LAS float* KN = (LAS float*)(lds + 6 * RARR); LAS float* YY = (LAS float*)(lds + 7 * RARR);
    LAS float* RKC = (LAS float*)(lds + 8 * RARR);
    LAS bf16* AW = (LAS bf16*)(lds + 4 * RARR); LAS bf16* AA = AW + 64 * 72; LAS bf16* AG = AA + 64 * 72; LAS bf16* AV = AG + 64 * 136;
    const bf16* XS = (const bf16*)(ws + WS_XS); const bf16* HV = (const bf16*)(ws + WS_HV);
    const bf16* Rg = (const bf16*)(ws + WS_R); const bf16* Kg = (const bf16*)(ws + WS_K); const bf16* Vg = (const bf16*)(ws + WS_V);
    bf16* VF = (bf16*)(ws + WS_VF); const bf16* E5 = (const bf16*)(ws + WS_E5); bf16* HN = (bf16*)(ws + WS_HN);
    const int fr = lane & 15, fq = lane >> 4, nt = wave & 3, mh = wave >> 2;
    const int colw = hd * 64 + 16 * nt + fr;
    bf16x8 fw[2], fa[2], fg[4], fv;
#pragma unroll
    for (int ks = 0; ks < 2; ++ks) { fw[ks] = frag_from_f32(a.in[I_W2] + ((size_t)l * 64 + 32 * ks + 8 * fq) * D + colw, D); fa[ks] = frag_from_f32(a.in[I_A2] + ((size_t)l * 64 + 32 * ks + 8 * fq) * D + colw, D); }
#pragma unroll
    for (int ks = 0; ks < 4; ++ks) fg[ks] = frag_from_f32(a.in[I_G2] + ((size_t)l * 128 + 32 * ks + 8 * fq) * D + colw, D);
    fv = fw[0];
    if (l > 0) fv = frag_from_f32(a.in[I_V2] + ((size_t)(l - 1) * 32 + 8 * fq) * D + colw, D);
    const float w0c = a.in[I_W0][l * D + colw], a0c = a.in[I_A0][l * D + colw], v0c = (l > 0) ? a.in[I_V0][(l - 1) * D + colw] : 0.f;
    const int t = tid >> 3, cg8 = tid & 7, c0 = hd * 64 + 8 * cg8;
    const float* mu = a.in[I_MU] + (size_t)l * 3328;
    float S[8];
#pragma unroll
    for (int i = 0; i < 8; ++i) S[i] = 0.f;
    const int vrow = 8 * wave + (lane >> 3), ks8 = lane & 7;
    for (int chunk = 0; chunk < 256; ++chunk) {
        const size_t row = (size_t)b * SEQ + (size_t)chunk * 64 + t;
        const bool hasprev = (chunk > 0) || (t > 0);
        {
            const bf16* xs = XS + row * 256; const float* mx = mu + 3072;
            float c[8], p[8], m[8], o[8];
            ld8bf(xs + 8 * cg8, c); if (hasprev) ld8bf(xs - 256 + 8 * cg8, p); else {
#pragma unroll
                for (int i = 0; i < 8; ++i) p[i] = 0.f; }
            ld8f(mx + 8 * cg8, m);
#pragma unroll
            for (int i = 0; i < 8; ++i) { const float s = c[i] + (p[i] - c[i]) * m[i]; o[i] = 2.0f * fsig(2.0f * s) - 1.0f; }
            *(LAS u32x4*)(AW + t * 72 + 8 * cg8) = pk8(o);
            ld8bf(xs + 64 + 8 * cg8, c); if (hasprev) ld8bf(xs - 256 + 64 + 8 * cg8, p);
            ld8f(mx + 64 + 8 * cg8, m);
#pragma unroll
            for (int i = 0; i < 8; ++i) o[i] = c[i] + (p[i] - c[i]) * m[i];
            *(LAS u32x4*)(AA + t * 72 + 8 * cg8) = pk8(o);
#pragma unroll
            for (int h8 = 0; h8 < 2; ++h8) {
                ld8bf(xs + 128 + 16 * cg8 + 8 * h8, c); if (hasprev) ld8bf(xs - 256 + 128 + 16 * cg8 + 8 * h8, p);
                ld8f(mx + 128 + 16 * cg8 + 8 * h8, m);
#pragma unroll
                for (int i = 0; i < 8; ++i) o[i] = fsig(c[i] + (p[i] - c[i]) * m[i]);
                *(LAS u32x4*)(AG + t * 136 + 16 * cg8 + 8 * h8) = pk8(o);
            }
            *(LAS u32x2*)(AV + t * 40 + 4 * cg8) = *(const u32x2*)(HV + row * 32 + 4 * cg8);
        }
        __syncthreads();
#pragma unroll
        for (int mi = 0; mi < 2; ++mi) {
            const int m = 2 * mh + mi;
            f32x4 cw = (f32x4){0.f, 0.f, 0.f, 0.f}, ca = cw, cgg = cw, cv = cw;
#pragma unroll
            for (int ks = 0; ks < 2; ++ks) { cw = __builtin_amdgcn_mfma_f32_16x16x32_bf16(*(const LAS bf16x8*)(AW + (16 * m + fr) * 72 + 32 * ks + 8 * fq), fw[ks], cw, 0, 0, 0);
                                              ca = __builtin_amdgcn_mfma_f32_16x16x32_bf16(*(const LAS bf16x8*)(AA + (16 * m + fr) * 72 + 32 * ks + 8 * fq), fa[ks], ca, 0, 0, 0); }
#pragma unroll
            for (int ks = 0; ks < 4; ++ks) cgg = __builtin_amdgcn_mfma_f32_16x16x32_bf16(*(const LAS bf16x8*)(AG + (16 * m + fr) * 136 + 32 * ks + 8 * fq), fg[ks], cgg, 0, 0, 0);
            if (l > 0) cv = __builtin_amdgcn_mfma_f32_16x16x32_bf16(*(const LAS bf16x8*)(AV + (16 * m + fr) * 40 + 8 * fq), fv, cv, 0, 0, 0);
#pragma unroll
            for (int rg = 0; rg < 4; ++rg) { const int o = (16 * m + 4 * fq + rg) * RST + 16 * nt + fr;
                PW[o] = expf(-0.6065306597f * fsig(w0c + cw[rg])); PA[o] = fsig(a0c + ca[rg]); PG[o] = cgg[rg]; PV[o] = fsig(v0c + cv[rg]); }
        }
        __syncthreads();
        {
            float r[8], k[8], v[8], p[8], m[8];
            ld8bf(Rg + row * D + c0, r); if (hasprev) ld8bf(Rg + (row - 1) * D + c0, p); else {
#pragma unroll
                for (int i = 0; i < 8; ++i) p[i] = 0.f; }
            ld8f(mu + c0, m);
#pragma unroll
            for (int i = 0; i < 8; ++i) r[i] += (p[i] - r[i]) * m[i];
            ld8bf(Kg + row * D + c0, k); if (hasprev) ld8bf(Kg + (row - 1) * D + c0, p);
            ld8f(mu + 1024 + c0, m);
#pragma unroll
            for (int i = 0; i < 8; ++i) k[i] += (p[i] - k[i]) * m[i];
            ld8bf(Vg + row * D + c0, v); if (hasprev) ld8bf(Vg + (row - 1) * D + c0, p);
            ld8f(mu + 2048 + c0, m);
#pragma unroll
            for (int i = 0; i < 8; ++i) v[i] += (p[i] - v[i]) * m[i];
            if (l == 0) *(u32x4*)(VF + row * D + c0) = pk8(v);
            else { float vf[8]; ld8bf(VF + row * D + c0, vf);
#pragma unroll
                for (int i = 0; i < 8; ++i) v[i] += (vf[i] - v[i]) * PV[t * RST + 8 * cg8 + i]; }
            float kkc[8], kac[8], rkk[8], av[8], kn[8];
            ld8f(a.in[I_KK] + l * D + c0, kkc); ld8f(a.in[I_KA] + l * D + c0, kac); ld8f(a.in[I_RK] + l * D + c0, rkk);
            float ss = 0.f, bon = 0.f;
#pragma unroll
            for (int i = 0; i < 8; ++i) { av[i] = PA[t * RST + 8 * cg8 + i]; kn[i] = k[i] * kkc[i]; ss += kn[i] * kn[i]; k[i] = k[i] * (1.0f + (av[i] - 1.0f) * kac[i]); bon += r[i] * k[i] * rkk[i]; }
            ss = red8(ss); bon = red8(bon);
            const float inv = 1.0f / fmaxf(sqrtf(ss), 1e-12f);
            if (cg8 == 0) RKC[t] = bon;
#pragma unroll
            for (int i = 0; i < 8; ++i) { const int o = t * RST + 8 * cg8 + i; kn[i] *= inv; RR[o] = r[i]; KK[o] = k[i]; KN[o] = kn[i]; PA[o] = kn[i] * av[i]; PV[o] = v[i]; }
        }
        __syncthreads();
#pragma unroll 2
        for (int s = 0; s < 64; ++s) {
            const f32x4 n0 = *(const LAS f32x4*)(KN + s * RST + 8 * ks8), n1 = *(const LAS f32x4*)(KN + s * RST + 8 * ks8 + 4);
            const f32x4 d0 = *(const LAS f32x4*)(PW + s * RST + 8 * ks8), d1 = *(const LAS f32x4*)(PW + s * RST + 8 * ks8 + 4);
            const f32x4 b0 = *(const LAS f32x4*)(PA + s * RST + 8 * ks8), b1 = *(const LAS f32x4*)(PA + s * RST + 8 * ks8 + 4);
            const f32x4 k0 = *(const LAS f32x4*)(KK + s * RST + 8 * ks8), k1 = *(const LAS f32x4*)(KK + s * RST + 8 * ks8 + 4);
            const f32x4 r0 = *(const LAS f32x4*)(RR + s * RST + 8 * ks8), r1 = *(const LAS f32x4*)(RR + s * RST + 8 * ks8 + 4);
            const float vv = PV[s * RST + vrow];
            float sa = (S[0] * n0.x + S[1] * n0.y) + (S[2] * n0.z + S[3] * n0.w) + (S[4] * n1.x + S[5] * n1.y) + (S[6] * n1.z + S[7] * n1.w);
            sa = -red8(sa);
            S[0] = S[0] * d0.x + sa * b0.x + vv * k0.x; S[1] = S[1] * d0.y + sa * b0.y + vv * k0.y; S[2] = S[2] * d0.z + sa * b0.z + vv * k0.z; S[3] = S[3] * d0.w + sa * b0.w + vv * k0.w;
            S[4] = S[4] * d1.x + sa * b1.x + vv * k1.x; S[5] = S[5] * d1.y + sa * b1.y + vv * k1.y; S[6] = S[6] * d1.z + sa * b1.z + vv * k1.z; S[7] = S[7] * d1.w + sa * b1.w + vv * k1.w;
            float y = (S[0] * r0.x + S[1] * r0.y) + (S[2] * r0.z + S[3] * r0.w) + (S[4] * r1.x + S[5] * r1.y) + (S[6] * r1.z + S[7] * r1.w);
            y = red8(y);
            if (ks8 == 0) YY[s * RST + vrow] = y;
        }
        __syncthreads();
        {
            float y[8], lg[8], lb[8], zc[8], hn[8], o[8];
            float sm = 0.f;
#pragma unroll
            for (int i = 0; i < 8; ++i) { y[i] = YY[t * RST + 8 * cg8 + i]; sm += y[i]; }
            const float mean = red8(sm) * (1.0f / 64.0f); float q = 0.f;
#pragma unroll
            for (int i = 0; i < 8; ++i) { y[i] -= mean; q += y[i] * y[i]; }
            const float rs = rsqrtf(red8(q) * (1.0f / 64.0f) + 64.0f * 1e-5f);
            ld8f(a.in[I_LNG] + l * D + c0, lg); ld8f(a.in[I_LNB] + l * D + c0, lb); ld8bf(E5 + row * D + c0, zc); ld8bf(HN + row * D + c0, hn);
            const float bon = RKC[t];
#pragma unroll
            for (int i = 0; i < 8; ++i) { const int oo = t * RST + 8 * cg8 + i; o[i] = hn[i] + ((y[i] * rs * lg[i] + lb[i]) + bon * PV[oo]) * PG[oo] * zc[i]; }
            *(u32x4*)(HN + row * D + c0) = pk8(o);
        }
        __syncthreads();
    }
}
typedef short bf16x4 __attribute__((ext_vector_type(4)));
__device__ __forceinline__ bf16x4 pk4(const f32x4 v) { u32x2 w; w.x = pk2(v[0], v[1]); w.y = pk2(v[2], v[3]); return __builtin_bit_cast(bf16x4, w); }
__device__ __forceinline__ f32x4 mfma16(bf16x4 a, bf16x4 b, f32x4 c) { return __builtin_amdgcn_mfma_f32_16x16x16bf16_1k(a, b, c, 0, 0, 0); }
__device__ __forceinline__ f32x4 mfma32(bf16x8 a, bf16x8 b, f32x4 c) { return __builtin_amdgcn_mfma_f32_16x16x32_bf16(a, b, c, 0, 0, 0); }
#define LDF8(p) (*(const LAS bf16x8*)(p))
#define BAR_LDS() do { asm volatile("s_waitcnt lgkmcnt(0)" ::: "memory"); __builtin_amdgcn_s_barrier(); asm volatile("" ::: "memory"); } while (0)
constexpr int TS = 72;
constexpr int TILE_B = 64 * TS * 2;
constexpr int XR_F32 = 0;
constexpr int XR_T = 4 * RARR;
constexpr int XR_SEG = XR_T + 7 * TILE_B;

__device__ __forceinline__ void rwkv_x1_phase(const Args& a, int l, LAS unsigned char* lds, int tid, int wave, int lane_unused) {
    size_t wz_ = 0; asm volatile("" : "+s"(wz_)); unsigned char* ws = a.ws + wz_;
    LAS float* LW = (LAS float*)(lds + XR_F32 + 0 * RARR); LAS float* PA = (LAS float*)(lds + XR_F32 + 1 * RARR); LAS float* PV = (LAS float*)(lds + XR_F32 + 2 * RARR); LAS float* PG = (LAS float*)(lds + XR_F32 + 3 * RARR);
    LAS bf16* Mab = (LAS bf16*)(lds + XR_F32); LAS bf16* Mak = Mab + 64 * TS; LAS bf16* Mrb = Mak + 64 * TS; LAS bf16* Mrk = Mrb + 64 * TS; LAS bf16* Xt = Mrk + 64 * TS;
    LAS bf16* At = (LAS bf16*)(lds + XR_T); LAS bf16* Rt = At + 64 * TS; LAS bf16* Bt = Rt + 64 * TS; LAS bf16* Kt = Bt + 64 * TS; LAS bf16* BhT = Kt + 64 * TS; LAS bf16* KhT = BhT + 64 * TS; LAS bf16* Vt = KhT + 64 * TS;
    LAS bf16* AW = (LAS bf16*)(lds + XR_T); LAS bf16* AA = AW + 64 * 72; LAS bf16* AG = AA + 64 * 72; LAS bf16* AV = AG + 64 * 136;
    LAS float* SEG = (LAS float*)(lds + XR_SEG); LAS bf16* TTl = (LAS bf16*)(lds + XR_SEG);
    const bf16* XS = (const bf16*)(ws + WS_XS); const bf16* HV = (const bf16*)(ws + WS_HV);
    const bf16* Rg = (const bf16*)(ws + WS_R); const bf16* Kg = (const bf16*)(ws + WS_K); const bf16* Vg = (const bf16*)(ws + WS_V);
    bf16* VF = (bf16*)(ws + WS_VF); bf16* E5 = (bf16*)(ws + WS_E5); bf16* HN = (bf16*)(ws + WS_HN);
    bf16* Qg = (bf16*)(ws + WS_E1); bf16* Y0g = (bf16*)(ws + WS_E2); bf16* Ptg = (bf16*)(ws + WS_E3); bf16* Hg = (bf16*)(ws + WS_E4); float* gCg = (float*)(ws + WS_AGA);
    const int nt = wave & 3, mh = wave >> 2;
    const float* mu = a.in[I_MU] + (size_t)l * 3328;
    int cur_bh = -1;
    bf16x8 fw[2], fa[2], fg[4], fv;
    float w0c = 0.f, a0c = 0.f, v0c = 0.f;
    u32x4 n_wc, n_wp, n_ac, n_ap, n_g0c, n_g0p, n_g1c, n_g1p; u32x2 n_hv;
#define X1_PF(u_, tt_) do { const int bh_ = (u_) & 31, ch_ = (u_) >> 5, t_ = (tt_) >> 3, c8_ = (tt_) & 7; \
        const size_t row_ = (size_t)(bh_ >> 4) * SEQ + (size_t)ch_ * 64 + t_; const size_t prow_ = (ch_ > 0 || t_ > 0) ? row_ - 1 : row_; \
        const bf16* xs_ = XS + row_ * 256; const bf16* xp_ = XS + prow_ * 256; \
        n_wc = *(const u32x4*)(xs_ + 8 * c8_); n_wp = *(const u32x4*)(xp_ + 8 * c8_); n_ac = *(const u32x4*)(xs_ + 64 + 8 * c8_); n_ap = *(const u32x4*)(xp_ + 64 + 8 * c8_); \
        n_g0c = *(const u32x4*)(xs_ + 128 + 16 * c8_); n_g0p = *(const u32x4*)(xp_ + 128 + 16 * c8_); n_g1c = *(const u32x4*)(xs_ + 136 + 16 * c8_); n_g1p = *(const u32x4*)(xp_ + 136 + 16 * c8_); \
        n_hv = *(const u32x2*)(HV + row_ * 32 + 4 * c8_); } while (0)
    if ((int)blockIdx.x < 8192) X1_PF((int)blockIdx.x, tid);
    for (int u = blockIdx.x; u < 8192; u += gridDim.x) {
        int tl_ = tid; asm volatile("" : "+v"(tl_));
        const int lane = tl_ & 63, fr = lane & 15, fq = lane >> 4, t = tl_ >> 3, cg8 = tl_ & 7;
        const int bh = u & 31, chunk = u >> 5, b = bh >> 4, hd = bh & 15;
        const size_t uidx = (size_t)chunk * 32 + bh;
        if (bh != cur_bh) {
            cur_bh = bh;
            const int colw = hd * 64 + 16 * nt + fr;
#pragma unroll
            for (int ks = 0; ks < 2; ++ks) { fw[ks] = frag_from_f32(a.in[I_W2] + ((size_t)l * 64 + 32 * ks + 8 * fq) * D + colw, D); fa[ks] = frag_from_f32(a.in[I_A2] + ((size_t)l * 64 + 32 * ks + 8 * fq) * D + colw, D); }
#pragma unroll
            for (int ks = 0; ks < 4; ++ks) fg[ks] = frag_from_f32(a.in[I_G2] + ((size_t)l * 128 + 32 * ks + 8 * fq) * D + colw, D);
            fv = fw[0];
            if (l > 0) fv = frag_from_f32(a.in[I_V2] + ((size_t)(l - 1) * 32 + 8 * fq) * D + colw, D);
            w0c = a.in[I_W0][l * D + colw]; a0c = a.in[I_A0][l * D + colw]; v0c = (l > 0) ? a.in[I_V0][(l - 1) * D + colw] : 0.f;
        }
        const int c0 = hd * 64 + 8 * cg8;
        const size_t row = (size_t)b * SEQ + (size_t)chunk * 64 + t;
        const bool hasprev = (chunk > 0) || (t > 0);
        const size_t prow = hasprev ? row - 1 : row; const float pm = hasprev ? 1.0f : 0.0f;
        const u32x4 q_rc = *(const u32x4*)(Rg + row * D + c0), q_rp = *(const u32x4*)(Rg + prow * D + c0);
        const u32x4 q_kc = *(const u32x4*)(Kg + row * D + c0), q_kp = *(const u32x4*)(Kg + prow * D + c0);
        const u32x4 q_vc = *(const u32x4*)(Vg + row * D + c0), q_vp = *(const u32x4*)(Vg + prow * D + c0);
        const u32x4 q_vf = *(const u32x4*)(VF + row * D + c0), q_zc = *(const u32x4*)(E5 + row * D + c0), q_hn = *(const u32x4*)(HN + row * D + c0);
        {
            const float* mx = mu + 3072;
            const u32x4 wc = n_wc, wp = n_wp, ac = n_ac, ap_ = n_ap, g0c = n_g0c, g0p = n_g0p, g1c = n_g1c, g1p = n_g1p; const u32x2 hvv = n_hv;
            float c[8], p[8], m[8], o[8];
            un8(wc, c); un8(wp, p); ld8f(mx + 8 * cg8, m);
#pragma unroll
            for (int i = 0; i < 8; ++i) { const float s = c[i] + (p[i] * pm - c[i]) * m[i]; o[i] = 2.0f * fsig(2.0f * s) - 1.0f; }
            *(LAS u32x4*)(AW + t * 72 + 8 * cg8) = pk8(o);
            un8(ac, c); un8(ap_, p); ld8f(mx + 64 + 8 * cg8, m);
#pragma unroll
            for (int i = 0; i < 8; ++i) o[i] = c[i] + (p[i] * pm - c[i]) * m[i];
            *(LAS u32x4*)(AA + t * 72 + 8 * cg8) = pk8(o);
            un8(g0c, c); un8(g0p, p); ld8f(mx + 128 + 16 * cg8, m);
#pragma unroll
            for (int i = 0; i < 8; ++i) o[i] = fsig(c[i] + (p[i] * pm - c[i]) * m[i]);
            *(LAS u32x4*)(AG + t * 136 + 16 * cg8) = pk8(o);
            un8(g1c, c); un8(g1p, p); ld8f(mx + 136 + 16 * cg8, m);
#pragma unroll
            for (int i = 0; i < 8; ++i) o[i] = fsig(c[i] + (p[i] * pm - c[i]) * m[i]);
            *(LAS u32x4*)(AG + t * 136 + 16 * cg8 + 8) = pk8(o);
            *(LAS u32x2*)(AV + t * 40 + 4 * cg8) = hvv;
        }
        BAR_LDS();
#pragma unroll
        for (int mi = 0; mi < 2; ++mi) {
            const int m = 2 * mh + mi;
            f32x4 cw = (f32x4){0.f, 0.f, 0.f, 0.f}, ca = cw, cgg = cw, cv = cw;
#pragma unroll
            for (int ks = 0; ks < 2; ++ks) { cw = mfma32(LDF8(AW + (16 * m + fr) * 72 + 32 * ks + 8 * fq), fw[ks], cw); ca = mfma32(LDF8(AA + (16 * m + fr) * 72 + 32 * ks + 8 * fq), fa[ks], ca); }
#pragma unroll
            for (int ks = 0; ks < 4; ++ks) cgg = mfma32(LDF8(AG + (16 * m + fr) * 136 + 32 * ks + 8 * fq), fg[ks], cgg);
            if (l > 0) cv = mfma32(LDF8(AV + (16 * m + fr) * 40 + 8 * fq), fv, cv);
#pragma unroll
            for (int rg = 0; rg < 4; ++rg) { const int o = (16 * m + 4 * fq + rg) * RST + 16 * nt + fr;
                LW[o] = -0.6065306597f * fsig(w0c + cw[rg]); PA[o] = fsig(a0c + ca[rg]); PG[o] = cgg[rg]; PV[o] = fsig(v0c + cv[rg]); }
        }
        BAR_LDS();
        {
            float pv[8]; float run = 0.f;
#pragma unroll
            for (int j = 0; j < 8; ++j) { run += LW[(8 * wave + j) * RST + lane]; pv[j] = run; }
            SEG[wave * 64 + lane] = run;
            BAR_LDS();
            float off = 0.f;
            for (int s = 0; s < wave; ++s) off += SEG[s * 64 + lane];
#pragma unroll
            for (int j = 0; j < 8; ++j) LW[(8 * wave + j) * RST + lane] = pv[j] + off;
        }
        BAR_LDS();
        {
            float r[8], k[8], v[8], p[8], m[8];
            un8(q_rc, r); un8(q_rp, p); ld8f(mu + c0, m);
#pragma unroll
            for (int i = 0; i < 8; ++i) r[i] += (p[i] * pm - r[i]) * m[i];
            un8(q_kc, k); un8(q_kp, p); ld8f(mu + 1024 + c0, m);
#pragma unroll
            for (int i = 0; i < 8; ++i) k[i] += (p[i] * pm - k[i]) * m[i];
            un8(q_vc, v); un8(q_vp, p); ld8f(mu + 2048 + c0, m);
#pragma unroll
            for (int i = 0; i < 8; ++i) v[i] += (p[i] * pm - v[i]) * m[i];
            if (l == 0) *(u32x4*)(VF + row * D + c0) = pk8(v);
            else { float vf[8]; un8(q_vf, vf);
#pragma unroll
                for (int i = 0; i < 8; ++i) v[i] += (vf[i] - v[i]) * PV[t * RST + 8 * cg8 + i]; }
            float kkc[8], kac[8], rkk[8], av[8], kn[8];
            ld8f(a.in[I_KK] + l * D + c0, kkc); ld8f(a.in[I_KA] + l * D + c0, kac); ld8f(a.in[I_RK] + l * D + c0, rkk);
            float ss = 0.f, bon = 0.f;
#pragma unroll
            for (int i = 0; i < 8; ++i) { av[i] = PA[t * RST + 8 * cg8 + i]; kn[i] = k[i] * kkc[i]; ss += kn[i] * kn[i]; k[i] = k[i] * (1.0f + (av[i] - 1.0f) * kac[i]); bon += r[i] * k[i] * rkk[i]; }
            ss = red8(ss); bon = red8(bon);
            const float inv = 1.0f / fmaxf(sqrtf(ss), 1e-12f);
            float oa[8], orr[8], ob[8], ok[8];
#pragma unroll
            for (int i = 0; i < 8; ++i) {
                const int lc = 8 * cg8 + i;
                const float Gt = LW[t * RST + lc], gpv_ = LW[((t > 0) ? t - 1 : 0) * RST + lc], Gp = (t > 0) ? gpv_ : 0.f, GC = LW[63 * RST + lc];
                const float knv = kn[i] * inv, bv = knv * av[i];
                const float eg = __expf(Gt), eng = __expf(-Gt), ecg = __expf(GC - Gt);
                oa[i] = -knv * __expf(Gp); orr[i] = r[i] * eg; ob[i] = bv * eng; ok[i] = k[i] * eng;
                BhT[lc * TS + t] = (bf16)f2bf(bv * ecg); KhT[lc * TS + t] = (bf16)f2bf(k[i] * ecg); Vt[lc * TS + t] = (bf16)f2bf(v[i]);
            }
            if (t == 63) {
#pragma unroll
                for (int i = 0; i < 8; ++i) gCg[uidx * 64 + 8 * cg8 + i] = expf(LW[63 * RST + 8 * cg8 + i]);
            }
            *(LAS u32x4*)(At + t * TS + 8 * cg8) = pk8(oa); *(LAS u32x4*)(Rt + t * TS + 8 * cg8) = pk8(orr);
            *(LAS u32x4*)(Bt + t * TS + 8 * cg8) = pk8(ob); *(LAS u32x4*)(Kt + t * TS + 8 * cg8) = pk8(ok);
            float lg[8], lb[8], zc[8], hn[8], g1[8], g2[8];
            ld8f(a.in[I_LNG] + l * D + c0, lg); ld8f(a.in[I_LNB] + l * D + c0, lb); un8(q_zc, zc); un8(q_hn, hn);
#pragma unroll
            for (int i = 0; i < 8; ++i) { const float gz = PG[t * RST + 8 * cg8 + i] * zc[i]; g1[i] = lg[i] * gz; g2[i] = hn[i] + (lb[i] + bon * v[i]) * gz; }
            *(u32x4*)(E5 + row * D + c0) = pk8(g1); *(u32x4*)(HN + row * D + c0) = pk8(g2);
        }
        BAR_LDS();
        {
            *(LAS u32x4*)(Xt + (16 * wave + (lane >> 2)) * TS + 16 * (lane & 3)) = (u32x4){0u, 0u, 0u, 0u};
            *(LAS u32x4*)(Xt + (16 * wave + (lane >> 2)) * TS + 16 * (lane & 3) + 8) = (u32x4){0u, 0u, 0u, 0u};
#pragma unroll
            for (int mi = 0; mi < 2; ++mi) {
                const int mt = 2 * mh + mi;
                f32x4 cab = (f32x4){0.f, 0.f, 0.f, 0.f}, cak = cab, crb = cab, crk = cab;
                if (nt <= mt) {
#pragma unroll
                    for (int ks = 0; ks < 2; ++ks) {
                        const bf16x8 fb = LDF8(Bt + (16 * nt + fr) * TS + 32 * ks + 8 * fq), fk = LDF8(Kt + (16 * nt + fr) * TS + 32 * ks + 8 * fq);
                        const bf16x8 fat = LDF8(At + (16 * mt + fr) * TS + 32 * ks + 8 * fq), frt = LDF8(Rt + (16 * mt + fr) * TS + 32 * ks + 8 * fq);
                        cab = mfma32(fb, fat, cab); cak = mfma32(fk, fat, cak); crb = mfma32(fb, frt, crb); crk = mfma32(fk, frt, crk);
                    }
                }
#pragma unroll
                for (int rg = 0; rg < 4; ++rg) { const int tl = fr, jl = 4 * fq + rg; const bool diag = (nt == mt);
                    const bool strict = !diag || (jl < tl), incl = !diag || (jl <= tl);
                    if (diag) cab[rg] = 0.f;
                    if (!strict) cak[rg] = 0.f;
                    if (!incl) { crb[rg] = 0.f; crk[rg] = 0.f; } }
                const int o = (16 * mt + fr) * TS + 16 * nt + 4 * fq;
                *(LAS bf16x4*)(Mab + o) = pk4(cab); *(LAS bf16x4*)(Mak + o) = pk4(cak); *(LAS bf16x4*)(Mrb + o) = pk4(crb); *(LAS bf16x4*)(Mrk + o) = pk4(crk);
            }
            if (wave < 4) { const int i = wave;
                f32x4 Pc = (f32x4){0.f, 0.f, 0.f, 0.f}, Pn = Pc;
#pragma unroll
                for (int ks = 0; ks < 2; ++ks) { const bf16x8 fat = LDF8(At + (16 * i + fr) * TS + 32 * ks + 8 * fq), fb = LDF8(Bt + (16 * i + fr) * TS + 32 * ks + 8 * fq);
                    Pc = mfma32(fat, fb, Pc); Pn = mfma32(fb, fat, Pn); }
                f32x4 Tc, Tn;
#pragma unroll
                for (int rg = 0; rg < 4; ++rg) { const int rr = 4 * fq + rg;
                    Pc[rg] = (fr < rr) ? Pc[rg] : 0.f;
                    Pn[rg] = (rr < fr) ? Pn[rg] : 0.f;
                    const float id = (rr == fr) ? 1.f : 0.f; Tc[rg] = id + Pc[rg]; Tn[rg] = id + Pn[rg]; }
#pragma unroll
                for (int st = 0; st < 3; ++st) {
                    const bf16x4 pcb = pk4(Pc), pnb = pk4(Pn);
                    const f32x4 z = (f32x4){0.f, 0.f, 0.f, 0.f};
                    const f32x4 P2 = mfma16(pnb, pcb, z), N2 = mfma16(pcb, pnb, z);
                    const bf16x4 tcb = pk4(Tc), tnb = pk4(Tn);
                    Tc = mfma16(tnb, pk4(P2), Tc); Tn = mfma16(tcb, pk4(N2), Tn);
                    Pc = P2; Pn = N2;
                }
                *(LAS bf16x4*)(TTl + (i * 64 + lane) * 4) = pk4(Tn);
            }
        }
        BAR_LDS();
        if (u + (int)gridDim.x < 8192) X1_PF(u + (int)gridDim.x, tl_);
        {
            bf16x4 tta[4];
#pragma unroll
            for (int i = 0; i < 4; ++i) tta[i] = *(const LAS bf16x4*)(TTl + (i * 64 + lane) * 4);
            LAS bf16* Xw = Xt + (16 * wave + fr) * TS;
#pragma unroll
            for (int i = 0; i < 4; ++i) {
                f32x4 acc = (f32x4){0.f, 0.f, 0.f, 0.f};
                if (wave < 4) {
#pragma unroll
                    for (int rg = 0; rg < 4; ++rg) acc[rg] = bf2f(At[(16 * i + 4 * fq + rg) * TS + 16 * wave + fr]);
                } else {
#pragma unroll
                    for (int ks = 0; ks < 2; ++ks) acc = mfma32(LDF8(Mak + (16 * i + fr) * TS + 32 * ks + 8 * fq), LDF8(Vt + (16 * (wave - 4) + fr) * TS + 32 * ks + 8 * fq), acc);
                }
                if (i > 0) {
#pragma unroll
                    for (int ks = 0; ks < 2; ++ks) acc = mfma32(LDF8(Mab + (16 * i + fr) * TS + 32 * ks + 8 * fq), LDF8(Xw + 32 * ks + 8 * fq), acc);
                }
                const f32x4 xi = mfma16(tta[i], pk4(acc), (f32x4){0.f, 0.f, 0.f, 0.f});
                *(LAS bf16x4*)(Xw + 16 * i + 4 * fq) = pk4(xi);
                LDS_WAIT();
            }
        }
        BAR_LDS();
        {
            bf16* Qu = Qg + uidx * 4096; bf16* Yu = Y0g + uidx * 4096; bf16* Pu = Ptg + uidx * 4096; bf16* Hu = Hg + uidx * 4096;
            const LAS bf16* Wt_ = Xt; const LAS bf16* U0t = Xt + 64 * TS;
#pragma unroll
            for (int mi = 0; mi < 2; ++mi) {
                const int mt = 2 * mh + mi;
                f32x4 cq = (f32x4){0.f, 0.f, 0.f, 0.f}, cy = cq, cp = cq, ch = cq;
#pragma unroll
                for (int ks = 0; ks < 2; ++ks) {
                    const int ko = 32 * ks + 8 * fq;
                    const bf16x8 wA = LDF8(Wt_ + (16 * mt + fr) * TS + ko), uA = LDF8(U0t + (16 * mt + fr) * TS + ko), vA = LDF8(Vt + (16 * mt + fr) * TS + ko);
                    const bf16x8 bhA = LDF8(BhT + (16 * mt + fr) * TS + ko), khA = LDF8(KhT + (16 * mt + fr) * TS + ko);
                    const bf16x8 rbB = LDF8(Mrb + (16 * nt + fr) * TS + ko), rkB = LDF8(Mrk + (16 * nt + fr) * TS + ko), bhB = LDF8(BhT + (16 * nt + fr) * TS + ko);
                    const bf16x8 uB = LDF8(U0t + (16 * nt + fr) * TS + ko), vB = LDF8(Vt + (16 * nt + fr) * TS + ko);
                    cq = mfma32(wA, rbB, cq);
                    cy = mfma32(uA, rbB, cy); cy = mfma32(vA, rkB, cy);
                    cp = mfma32(wA, bhB, cp);
                    ch = mfma32(bhA, uB, ch); ch = mfma32(khA, vB, ch);
                }
                { const u32x2 rw = *(const LAS u32x2*)(Rt + (16 * nt + fr) * TS + 16 * mt + 4 * fq); cq[0] += bflo(rw.x); cq[1] += bfhi(rw.x); cq[2] += bflo(rw.y); cq[3] += bfhi(rw.y); }
                const int o = (16 * nt + fr) * 64 + 16 * mt + 4 * fq;
                *(bf16x4*)(Qu + o) = pk4(cq); *(bf16x4*)(Yu + o) = pk4(cy); *(bf16x4*)(Pu + o) = pk4(cp); *(bf16x4*)(Hu + o) = pk4(ch);
            }
        }
        BAR_LDS();
    }
}
__device__ __forceinline__ void rwkv_x2_phase(const Args& a, LAS unsigned char* lds, int wave, int lane) {
    if (blockIdx.x >= 128) return;
    size_t wz_ = 0; asm volatile("" : "+s"(wz_)); unsigned char* ws = a.ws + wz_;
    const int bh = blockIdx.x >> 2, vb = blockIdx.x & 3, fr = lane & 15, fq = lane >> 4;
    const bf16* Ptg = (const bf16*)(ws + WS_E3); const bf16* Hg = (const bf16*)(ws + WS_E4); const float* gCg = (const float*)(ws + WS_AGA); bf16* Sg = (bf16*)(ws + WS_R);
    LAS bf16* St = (LAS bf16*)lds;
    if (wave < 4) {
        f32x4 S = (f32x4){0.f, 0.f, 0.f, 0.f};
        bf16x8 pa0[8], pa1[8]; u32x2 hh[8]; f32x4 gc[8];
        const bf16* pbase = Ptg + (size_t)bh * 4096 + (16 * wave + fr) * 64 + 8 * fq; const bf16* hbase = Hg + (size_t)bh * 4096 + (16 * vb + fr) * 64 + 16 * wave + 4 * fq; const float* gbase = gCg + (size_t)bh * 64 + 16 * wave + 4 * fq;
#define X2_LD(set_, chunk_) do { const size_t co_ = (size_t)(chunk_) * 32; pa0[set_] = *(const bf16x8*)(pbase + co_ * 4096); pa1[set_] = *(const bf16x8*)(pbase + co_ * 4096 + 32); \
            hh[set_] = *(const u32x2*)(hbase + co_ * 4096); gc[set_] = *(const f32x4*)(gbase + co_ * 64); } while (0)
#pragma unroll
        for (int j = 0; j < 8; ++j) X2_LD(j, j);
        for (int s0 = 0; s0 < 256; s0 += 8) {
#pragma unroll
            for (int j = 0; j < 8; ++j) {
                const int s = s0 + j;
                LAS bf16* Sc = St + (j & 1) * 16 * TS;
                *(LAS bf16x4*)(Sc + fr * TS + 16 * wave + 4 * fq) = pk4(S);
                BAR_LDS();
                const bf16x8 sb0 = LDF8(Sc + fr * TS + 8 * fq), sb1 = LDF8(Sc + fr * TS + 32 + 8 * fq);
                f32x4 nw = mfma32(pa0[j], sb0, (f32x4){0.f, 0.f, 0.f, 0.f}); nw = mfma32(pa1[j], sb1, nw);
                S[0] = S[0] * gc[j][0] + nw[0] + bflo(hh[j].x); S[1] = S[1] * gc[j][1] + nw[1] + bfhi(hh[j].x);
                S[2] = S[2] * gc[j][2] + nw[2] + bflo(hh[j].y); S[3] = S[3] * gc[j][3] + nw[3] + bfhi(hh[j].y);
                const int nx = (s + 8 < 256) ? s + 8 : 255;
                X2_LD(j, nx);
            }
        }
#undef X2_LD
    } else {
        const int myr = wave - 4;
        for (int s = 0; s < 256; ++s) {
            BAR_LDS();
            if ((s & 3) == myr) {
                const LAS bf16* sp_ = St + (s & 1) * 16 * TS + fr * TS + 4 * fq; bf16* Su_ = Sg + ((size_t)s * 32 + bh) * 4096 + (16 * vb + fr) * 64 + 4 * fq;
#pragma unroll
                for (int mt = 0; mt < 4; ++mt) *(u32x2*)(Su_ + 16 * mt) = *(const LAS u32x2*)(sp_ + 16 * mt);
            }
        }
    }
}
__device__ __forceinline__ void rwkv_x3_phase(const Args& a, LAS unsigned char* lds, int tid, int wave, int lane) {
    size_t wz_ = 0; asm volatile("" : "+s"(wz_)); unsigned char* ws = a.ws + wz_;
    const bf16* Qg = (const bf16*)(ws + WS_E1); const bf16* Y0g = (const bf16*)(ws + WS_E2); const bf16* Sg = (const bf16*)(ws + WS_R); const bf16* E5 = (const bf16*)(ws + WS_E5); bf16* HN = (bf16*)(ws + WS_HN);
    const int fr = lane & 15, fq = lane >> 4, nt = wave & 3, mh = wave >> 2, t = tid >> 3, cg8 = tid & 7;
    int par = 0;
    bf16x8 nS[2][2], nQ[2]; u32x2 nY[2]; u32x4 n_g1, n_hn;
#define X3_PF(u_) do { const int bh_ = (u_) & 31, ch_ = (u_) >> 5; const size_t ui_ = (size_t)ch_ * 32 + bh_; \
        const bf16* Su_ = Sg + ui_ * 4096; const bf16* Qu_ = Qg + ui_ * 4096; const bf16* Yu_ = Y0g + ui_ * 4096; \
        _Pragma("unroll") for (int mi = 0; mi < 2; ++mi) { _Pragma("unroll") for (int ks = 0; ks < 2; ++ks) nS[mi][ks] = *(const bf16x8*)(Su_ + (16 * (2 * mh + mi) + fr) * 64 + 32 * ks + 8 * fq); \
            nY[mi] = *(const u32x2*)(Yu_ + (16 * nt + fr) * 64 + 16 * (2 * mh + mi) + 4 * fq); } \
        _Pragma("unroll") for (int ks = 0; ks < 2; ++ks) nQ[ks] = *(const bf16x8*)(Qu_ + (16 * nt + fr) * 64 + 32 * ks + 8 * fq); \
        const size_t row_ = (size_t)(bh_ >> 4) * SEQ + (size_t)ch_ * 64 + t; const int c0_ = (bh_ & 15) * 64 + 8 * cg8; \
        n_g1 = *(const u32x4*)(E5 + row_ * D + c0_); n_hn = *(const u32x4*)(HN + row_ * D + c0_); } while (0)
    X3_PF((int)blockIdx.x);
    for (int u = blockIdx.x; u < 8192; u += gridDim.x, par ^= 1) {
        const int bh = u & 31, chunk = u >> 5, b = bh >> 4, hd = bh & 15;
        LAS float* YY = (LAS float*)(lds + par * RARR);
        const int c0 = hd * 64 + 8 * cg8; const size_t row = (size_t)b * SEQ + (size_t)chunk * 64 + t;
        bf16x8 cS[2][2], cQ[2]; u32x2 cY[2];
#pragma unroll
        for (int mi = 0; mi < 2; ++mi) { cS[mi][0] = nS[mi][0]; cS[mi][1] = nS[mi][1]; cY[mi] = nY[mi]; }
        cQ[0] = nQ[0]; cQ[1] = nQ[1];
        const u32x4 q_g1 = n_g1, q_hn = n_hn;
        if (u + (int)gridDim.x < 8192) X3_PF(u + (int)gridDim.x);
#pragma unroll
        for (int mi = 0; mi < 2; ++mi) {
            const int mt = 2 * mh + mi;
            f32x4 c = (f32x4){0.f, 0.f, 0.f, 0.f};
#pragma unroll
            for (int ks = 0; ks < 2; ++ks) c = mfma32(cS[mi][ks], cQ[ks], c);
            const u32x2 yw = cY[mi];
            c[0] += bflo(yw.x); c[1] += bfhi(yw.x); c[2] += bflo(yw.y); c[3] += bfhi(yw.y);
            *(LAS f32x4*)(YY + (16 * nt + fr) * RST + 16 * mt + 4 * fq) = c;
        }
        BAR_LDS();
        {
            float y[8], g1[8], hn[8], o[8]; float sm = 0.f;
#pragma unroll
            for (int i = 0; i < 8; ++i) { y[i] = YY[t * RST + 8 * cg8 + i]; sm += y[i]; }
            const float mean = red8(sm) * (1.0f / 64.0f); float q = 0.f;
#pragma unroll
            for (int i = 0; i < 8; ++i) { y[i] -= mean; q += y[i] * y[i]; }
            const float rs = rsqrtf(red8(q) * (1.0f / 64.0f) + 64.0f * 1e-5f);
            un8(q_g1, g1); un8(q_hn, hn);
#pragma unroll
            for (int i = 0; i < 8; ++i) o[i] = hn[i] + y[i] * rs * g1[i];
            *(u32x4*)(HN + row * D + c0) = pk8(o);
        }
    }
    BAR_LDS();
}


#define RLX_AGENT __ATOMIC_RELAXED, __HIP_MEMORY_SCOPE_AGENT
#define XB_TMO      128
#define XB_XCNT(j)  (256  + 64 * (j))
#define XB_XSUB(j)  (1280 + 64 * (j))
#define XB_XGEN(j)  (2304 + 64 * (j))
#define XB_TOP      3328
#define XB_TOPGEN   3392
#define XCD_BAR_WORDS 3456
#define XB_SPIN_CAP (1u << 18)

__device__ __forceinline__ unsigned xb_ld(unsigned* p)              { return __hip_atomic_load(p, __ATOMIC_RELAXED, __HIP_MEMORY_SCOPE_AGENT); }
__device__ __forceinline__ unsigned xb_add(unsigned* p, unsigned v) { return __hip_atomic_fetch_add(p, v, __ATOMIC_RELAXED, __HIP_MEMORY_SCOPE_AGENT); }
__device__ __forceinline__ unsigned xb_xcc_id() { return (unsigned)__builtin_amdgcn_s_getreg((3 << 11) | 20) & 0xFu; }
#define XB_SPIN(cond, bar) do { unsigned _sp = 0; while (cond) { __builtin_amdgcn_s_sleep(1); \
    if ((++_sp & 255u) == 0u) { if (xb_ld(&(bar)[XB_TMO])) break; if (_sp > XB_SPIN_CAP) { atomicAdd(&(bar)[XB_TMO], 1u); break; } } } } while (0)

struct XcdBarrier {
    unsigned* bar; unsigned x;
    volatile LAS unsigned* st;
};

__device__ __forceinline__ XcdBarrier xcd_barrier_post(unsigned* bar, volatile LAS unsigned* st) {
    XcdBarrier b; b.bar = bar; b.x = xb_xcc_id(); b.st = st;
    if (threadIdx.x == 0) (void)xb_add(&bar[XB_XCNT(b.x)], 1u);
    return b;
}
__device__ __forceinline__ void xcd_barrier_complete(unsigned* bar, unsigned x, unsigned& nloc, unsigned& nx) {
    const unsigned G = gridDim.x * gridDim.y * gridDim.z;
    unsigned sum, cnt, mine, sp = 0u;
    for (;;) {
        sum = 0u; cnt = 0u; mine = 0u;
#pragma unroll
        for (unsigned j = 0; j < 16; ++j) { const unsigned c = xb_ld(&bar[XB_XCNT(j)]); sum += c; cnt += (c > 0u) ? 1u : 0u; mine = (j == x) ? c : mine; }
        if (sum == G) break;
        __builtin_amdgcn_s_sleep(1);
        if ((++sp & 255u) == 0u) { if (xb_ld(&bar[XB_TMO])) break; if (sp > XB_SPIN_CAP) { atomicAdd(&bar[XB_TMO], 1u); break; } }
    }
    nloc = mine > 0u ? mine : 1u; nx = cnt > 0u ? cnt : 1u;
}

__device__ __forceinline__ void xcd_barrier(const XcdBarrier& b) {
    asm volatile("s_waitcnt vmcnt(0)" ::: "memory");
    __syncthreads();
    if (threadIdx.x == 0) {
        unsigned* bar = b.bar;
        __builtin_amdgcn_s_waitcnt(0);
        unsigned nloc = b.st[0], nx = b.st[1];
        if (nloc == 0u) { xcd_barrier_complete(bar, b.x, nloc, nx); b.st[0] = nloc; b.st[1] = nx; }
        const unsigned old = xb_add(&bar[XB_XSUB(b.x)], 1u);
        const unsigned gen = old / nloc;
        if (old + 1u == (gen + 1u) * nloc) {
            __builtin_amdgcn_fence(__ATOMIC_RELEASE, "agent");
            asm volatile("s_waitcnt vmcnt(0)" ::: "memory");
            const unsigned og = xb_add(&bar[XB_TOP], 1u);
            const unsigned tg = og / nx;
            if (og + 1u == (tg + 1u) * nx) xb_add(&bar[XB_TOPGEN], 1u);
            else XB_SPIN(xb_ld(&bar[XB_TOPGEN]) == tg, bar);
            __builtin_amdgcn_fence(__ATOMIC_ACQUIRE, "agent");
            xb_add(&bar[XB_XGEN(b.x)], 1u);
            asm volatile("s_waitcnt vmcnt(0)" ::: "memory");
        } else {
            XB_SPIN(xb_ld(&bar[XB_XGEN(b.x)]) == gen, bar);
            __builtin_amdgcn_fence(__ATOMIC_ACQUIRE, "agent");
            asm volatile("s_waitcnt vmcnt(0)" ::: "memory");
        }
    }
    __syncthreads();
}

__global__ void __launch_bounds__(NTHREADS, 2) fwd_megakernel(Args a) {
    extern __shared__ __attribute__((aligned(16))) unsigned char lds_raw[];
    cg::grid_group grid = cg::this_grid();
    LAS unsigned char* lds = (LAS unsigned char*)lds_raw;
    const int tid = threadIdx.x, lane0 = tid & 63, wave = __builtin_amdgcn_readfirstlane(tid >> 6);
    const int G = gridDim.x, gw = blockIdx.x * NWAVES + wave, NGW = G * NWAVES;
    unsigned char* ws = a.ws;
    bf16* HN = (bf16*)(ws + WS_HN);
    float* X = a.out;
    volatile LAS unsigned* MISC = (volatile LAS unsigned*)(lds + LDS_BYTES - 64);
    if (tid < 16) MISC[tid] = 0u;
    __syncthreads();
    const XcdBarrier xbar = xcd_barrier_post((unsigned*)ws, MISC);
    bool first_seam = true;
#define GRID_BAR() do { if (first_seam) { grid.sync(); first_seam = false; } else xcd_barrier(xbar); } while (0)
    for (int l = 0; l < DEPTH; ++l) {
        int lane = tid; asm volatile("" : "+v"(lane)); lane &= 63;
        const float* xin = (l == 0) ? a.in[I_X] : X;
        convert_weights(a, l, lds, gw, NGW, wave, lane, (l == 0 || G <= 128) ? 0 : 2);
        rms_rows_bf16(xin, a.in[I_N1G] + l * D, HN, gw, NGW, lane);
        GRID_BAR();
        { pg8::Gemm g{HN, (const bf16*)(ws + WS_WIN), T, NP, D}; pg8::StaticOrder S; S.init(T, NP, G, (int)blockIdx.x);
          pg8::EpiIn E{(bf16*)(ws + WS_E1), (bf16*)(ws + WS_XS), (bf16*)(ws + WS_HV), a.in[I_MB] + l * 3072};
          pg8::gemm_phase<pg8::EpiIn, pg8::StaticOrder, true, true>(lds, g, S, E); }
        GRID_BAR();
                {
            int tid_l = tid; asm volatile("" : "+v"(tid_l));
            lru_phase<false>(a, l, lds, gw, NGW, wave, lane);
            GRID_BAR();
            lru_carry_phase(a, lds, wave, lane);
            GRID_BAR();
            lru_phase<true>(a, l, lds, gw, NGW, wave, lane);
            GRID_BAR();
            rwkv_x1_phase(a, l, lds, tid_l, wave, lane);
            GRID_BAR();
            rwkv_x2_phase(a, lds, wave, lane);
            if ((int)blockIdx.x >= 128 && l + 1 < DEPTH) convert_weights(a, l + 1, lds, ((int)blockIdx.x - 128) * NWAVES + wave, (G - 128) * NWAVES, wave, lane, 1);
            GRID_BAR();
            rwkv_x3_phase(a, lds, tid_l, wave, lane);
            GRID_BAR();
        }

        { pg8::Gemm g{HN, (const bf16*)(ws + WS_WOUT), T, D, D}; pg8::StaticOrder S; S.init(T, D, G, (int)blockIdx.x);
          pg8::EpiRes E{xin, X};
          pg8::gemm_phase<pg8::EpiRes, pg8::StaticOrder, true, true>(lds, g, S, E); }
        GRID_BAR();
        rms_rows_bf16(X, a.in[I_N2G] + l * D, HN, gw, NGW, lane);
        GRID_BAR();
        { pg8::Gemm g{HN, (const bf16*)(ws + WS_W1), T, FF, D}; pg8::StaticOrder S; S.init(T, FF, G, (int)blockIdx.x);
          pg8::EpiRelu2 E{(bf16*)(ws + WS_HID)};
          pg8::gemm_phase<pg8::EpiRelu2, pg8::StaticOrder, true, true>(lds, g, S, E); }
        GRID_BAR();
        { pg8::Gemm g{(const bf16*)(ws + WS_HID), (const bf16*)(ws + WS_W2), T, D, FF}; pg8::StaticOrder S; S.init(T, D, G, (int)blockIdx.x);
          pg8::EpiRes E{X, X};
          pg8::gemm_phase<pg8::EpiRes, pg8::StaticOrder, true, true>(lds, g, S, E); }
        GRID_BAR();
    }
    { int lf = tid; asm volatile("" : "+v"(lf)); lf &= 63;
      rms_rows_f32(X, a.in[I_FG], gw, NGW, lf); }
}

extern "C" void kernel_launch(void* const* d_in, const int* in_sizes, int n_in, void* d_out, int out_size, void* d_ws, size_t ws_size, hipStream_t stream) {
    static int grid = 0;
    if (grid == 0) {
        if (n_in != 31 || out_size != T * D || ws_size < WS_END) { fprintf(stderr, "kernel_launch: unexpected problem: n_in %d out %d ws %zu (need %zu)\n", n_in, out_size, ws_size, (size_t)WS_END); grid = -1; return; }
        int dev = 0, cus = 0, per_cu = 0;
        hipGetDevice(&dev); hipDeviceGetAttribute(&cus, hipDeviceAttributeMultiprocessorCount, dev);
        if (hipFuncSetAttribute((const void*)fwd_megakernel, hipFuncAttributeMaxDynamicSharedMemorySize, LDS_BYTES) != hipSuccess) { fprintf(stderr, "kernel_launch: hipFuncSetAttribute failed\n"); grid = -1; return; }
        if (hipOccupancyMaxActiveBlocksPerMultiprocessor(&per_cu, (const void*)fwd_megakernel, NTHREADS, LDS_BYTES) != hipSuccess || per_cu < 1) { fprintf(stderr, "kernel_launch: occupancy query says %d\n", per_cu); per_cu = 1; }
        (void)hipGetLastError();
        grid = cus * per_cu;
        fprintf(stderr, "kernel_launch: grid %d (cus %d x %d) ws %zu\n", grid, cus, per_cu, ws_size);
    }
    if (grid < 0) return;
    if (hipMemsetAsync(d_ws, 0, 16384, stream) != hipSuccess) { fprintf(stderr, "kernel_launch: memset of the barrier words failed\n"); return; }
    Args a{};
    for (int i = 0; i < 31; ++i) a.in[i] = (const float*)d_in[i];
    a.out = (float*)d_out; a.ws = (unsigned char*)d_ws;
    void* args[] = {&a};
    hipError_t e = hipLaunchCooperativeKernel((const void*)fwd_megakernel, dim3(grid), dim3(NTHREADS), args, LDS_BYTES, stream);
    if (e != hipSuccess) fprintf(stderr, "cooperative launch failed: %s (grid %d)\n", hipGetErrorString(e), grid);
}
```
